# Optimizing an MI355X kernel written in HIP

```python
import jax, jax.numpy as jnp
from jax import lax
import numpy as np

D_MODEL = 1024
BATCH = 8
SEQ = 2048
DEPTH = 1

MIX_WIDTH = D_MODEL
HEAD_DIM = 64
ATTN_WIDTH = MIX_WIDTH // 2
N_ATTN_HEADS = ATTN_WIDTH // HEAD_DIM
DILATED_BRANCHES = ((128, 1), (512, 4), (2048, 16))
Q_BLOCK = 128
ROPE_THETA = 10000.0
SSD_WIDTH = MIX_WIDTH - ATTN_WIDTH
SSD_HEAD_DIM = 64
N_SSD_HEADS = SSD_WIDTH // SSD_HEAD_DIM
N_SSD_GROUPS = 2
SSD_STATE = 128
CONV_WIDTH = 4
CHUNK = 128
D_FF = 4 * D_MODEL
EPS = 1e-6
CONV_CHANNELS = SSD_WIDTH + 2 * N_SSD_GROUPS * SSD_STATE
IN_PROJ_WIDTH = 3 * ATTN_WIDTH + SSD_WIDTH + CONV_CHANNELS + N_SSD_HEADS

kernel_name = "hybrid_dilated_attn_ssd_block"


def rms_norm(x, w):
    xf = x.astype(jnp.float32)
    y = xf * lax.rsqrt(jnp.mean(xf * xf, axis=-1, keepdims=True) + EPS)
    return (y * w.astype(jnp.float32)).astype(x.dtype)


def rope(x):
    s, d = x.shape[1], x.shape[-1]
    half = d // 2
    inv_freq = ROPE_THETA ** (-jnp.arange(half, dtype=jnp.float32) / half)
    ang = jnp.arange(s, dtype=jnp.float32)[:, None] * inv_freq[None, :]
    cos = jnp.cos(ang)[None, :, None, :]
    sin = jnp.sin(ang)[None, :, None, :]
    xf = x.astype(jnp.float32)
    x1, x2 = xf[..., :half], xf[..., half:]
    out = jnp.concatenate([x1 * cos - x2 * sin, x2 * cos + x1 * sin], axis=-1)
    return out.astype(x.dtype)


def dilated_attention(q, k, v):
    b, h, s, d = q.shape
    nb = s // Q_BLOCK
    scale = d ** -0.5
    q_blocks = q.reshape(b, h, nb, Q_BLOCK, d).transpose(2, 0, 1, 3, 4)
    t_blocks = jnp.arange(s, dtype=jnp.int32).reshape(nb, Q_BLOCK)

    def block(args):
        qb, tb = args
        outs, lses = [], []
        for window, dil in DILATED_BRANCHES:
            n_keys = window // dil + 1
            idx = tb[:, None] - dil * jnp.arange(n_keys, dtype=jnp.int32)[None, :]
            valid = idx >= 0
            flat = jnp.maximum(idx, 0).reshape(-1)
            kg = jnp.take(k, flat, axis=2).reshape(b, h, Q_BLOCK, n_keys, d)
            vg = jnp.take(v, flat, axis=2).reshape(b, h, Q_BLOCK, n_keys, d)
            sc = jnp.einsum("bhqd,bhqkd->bhqk", qb, kg).astype(jnp.float32) * scale
            sc = jnp.where(valid, sc, -jnp.inf)
            lse = jax.nn.logsumexp(sc, axis=-1)
            p = jnp.exp(sc - lse[..., None])
            o = jnp.einsum("bhqk,bhqkd->bhqd", p.astype(v.dtype), vg)
            outs.append(o.astype(jnp.float32))
            lses.append(lse)
        wts = jax.nn.softmax(jnp.stack(lses, axis=0), axis=0)
        o = jnp.sum(wts[..., None] * jnp.stack(outs, axis=0), axis=0)
        return o.astype(q.dtype)

    o = lax.map(block, (q_blocks, t_blocks))
    return o.transpose(1, 2, 0, 3, 4).reshape(b, h, s, d)


def causal_depthwise_conv(u, w, bias):
    s = u.shape[1]
    up = jnp.pad(u, ((0, 0), (CONV_WIDTH - 1, 0), (0, 0)))
    out = bias
    for tap in range(CONV_WIDTH):
        out = out + up[:, tap:tap + s, :] * w[tap]
    return out


def ssd_scan(x, dt, a, b_mat, c_mat):
    bsz, s, h, p = x.shape
    g, n = b_mat.shape[-2:]
    r = h // g
    nc = s // CHUNK
    xc = (x * dt[..., None]).reshape(bsz, nc, CHUNK, g, r, p)
    a_dt = (dt * a).reshape(bsz, nc, CHUNK, g, r)
    bc = b_mat.reshape(bsz, nc, CHUNK, g, n)
    cc = c_mat.reshape(bsz, nc, CHUNK, g, n)
    a_cs = jnp.cumsum(a_dt, axis=2)
    a_cs_t = jnp.moveaxis(a_cs, 2, -1)
    causal = jnp.tril(jnp.ones((CHUNK, CHUNK), dtype=bool))
    seg = jnp.exp(jnp.where(causal, a_cs_t[..., :, None] - a_cs_t[..., None, :], -jnp.inf))
    cb = jnp.einsum("bclgn,bcsgn->bcgls", cc, bc)
    y_diag = jnp.einsum("bcgls,bcgrls,bcsgrp->bclgrp", cb, seg, xc)
    decay_to_end = jnp.exp(a_cs[:, :, -1:] - a_cs)
    chunk_states = jnp.einsum("bclgn,bclgr,bclgrp->bcgrpn", bc, decay_to_end, xc)
    chunk_decay = jnp.exp(a_cs[:, :, -1])

    def step(state, inp):
        cs, dec = inp
        return dec[..., None, None] * state + cs, state

    init = jnp.zeros((bsz, g, r, p, n), dtype=x.dtype)
    _, states_in = lax.scan(step, init, (jnp.moveaxis(chunk_states, 1, 0),
                                         jnp.moveaxis(chunk_decay, 1, 0)))
    states_in = jnp.moveaxis(states_in, 0, 1)
    y_off = jnp.einsum("bclgn,bcgrpn,bclgr->bclgrp", cc, states_in, jnp.exp(a_cs))
    return (y_diag + y_off).reshape(bsz, s, h, p)


def setup_inputs(seed: int = 0) -> dict:
    key = jax.random.key(seed)
    ks = jax.random.split(key, 16)
    f32 = jnp.float32
    x = jax.random.normal(ks[0], (BATCH, SEQ, D_MODEL), f32)
    attn_norm_w = 1.0 + 0.02 * jax.random.normal(ks[1], (DEPTH, D_MODEL), f32)
    w_in = jax.random.normal(ks[2], (DEPTH, D_MODEL, IN_PROJ_WIDTH), f32) * D_MODEL ** -0.5
    q_norm_w = 1.0 + 0.02 * jax.random.normal(ks[3], (DEPTH, HEAD_DIM), f32)
    k_norm_w = 1.0 + 0.02 * jax.random.normal(ks[4], (DEPTH, HEAD_DIM), f32)
    conv_w = jax.random.normal(ks[5], (DEPTH, CONV_WIDTH, CONV_CHANNELS), f32) * CONV_WIDTH ** -0.5
    conv_b = 0.01 * jax.random.normal(ks[6], (DEPTH, CONV_CHANNELS), f32)
    dt0 = jnp.exp(jax.random.uniform(ks[7], (DEPTH, N_SSD_HEADS), f32,
                                     minval=math_log(0.001), maxval=math_log(0.1)))
    dt_bias = dt0 + jnp.log(-jnp.expm1(-dt0))
    a_log = jnp.log(jax.random.uniform(ks[8], (DEPTH, N_SSD_HEADS), f32, minval=1.0, maxval=16.0))
    d_skip = 1.0 + 0.1 * jax.random.normal(ks[9], (DEPTH, N_SSD_HEADS), f32)
    ssd_norm_w = 1.0 + 0.02 * jax.random.normal(ks[10], (DEPTH, SSD_WIDTH), f32)
    w_out = jax.random.normal(ks[11], (DEPTH, MIX_WIDTH, D_MODEL), f32) * MIX_WIDTH ** -0.5
    mlp_norm_w = 1.0 + 0.02 * jax.random.normal(ks[12], (DEPTH, D_MODEL), f32)
    w_up = jax.random.normal(ks[13], (DEPTH, D_MODEL, D_FF), f32) * D_MODEL ** -0.5
    w_down = jax.random.normal(ks[14], (DEPTH, D_FF, D_MODEL), f32) * D_FF ** -0.5
    return {"x": x, "attn_norm_w": attn_norm_w, "w_in": w_in, "q_norm_w": q_norm_w,
            "k_norm_w": k_norm_w, "conv_w": conv_w, "conv_b": conv_b, "dt_bias": dt_bias,
            "a_log": a_log, "d_skip": d_skip, "ssd_norm_w": ssd_norm_w, "w_out": w_out,
            "mlp_norm_w": mlp_norm_w, "w_up": w_up, "w_down": w_down}


def math_log(v):
    return float(np.log(v))


def reference(x, attn_norm_w, w_in, q_norm_w, k_norm_w, conv_w, conv_b, dt_bias,
              a_log, d_skip, ssd_norm_w, w_out, mlp_norm_w, w_up, w_down):
    b, s, _ = x.shape
    splits = np.cumsum([ATTN_WIDTH, ATTN_WIDTH, ATTN_WIDTH, SSD_WIDTH, CONV_CHANNELS]).tolist()
    for i in range(DEPTH):
        h = rms_norm(x, attn_norm_w[i])
        proj = h @ w_in[i]
        q, k, v, z, xbc, dt_raw = jnp.split(proj, splits, axis=-1)

        q = rope(rms_norm(q.reshape(b, s, N_ATTN_HEADS, HEAD_DIM), q_norm_w[i]))
        k = rope(rms_norm(k.reshape(b, s, N_ATTN_HEADS, HEAD_DIM), k_norm_w[i]))
        v = v.reshape(b, s, N_ATTN_HEADS, HEAD_DIM)
        o_attn = dilated_attention(q.transpose(0, 2, 1, 3), k.transpose(0, 2, 1, 3),
                                   v.transpose(0, 2, 1, 3))
        o_attn = o_attn.transpose(0, 2, 1, 3).reshape(b, s, ATTN_WIDTH)

        xbc = jax.nn.silu(causal_depthwise_conv(xbc, conv_w[i], conv_b[i]))
        xs, bm, cm = jnp.split(xbc, [SSD_WIDTH, SSD_WIDTH + N_SSD_GROUPS * SSD_STATE], axis=-1)
        xs = xs.astype(jnp.float32).reshape(b, s, N_SSD_HEADS, SSD_HEAD_DIM)
        bm = bm.astype(jnp.float32).reshape(b, s, N_SSD_GROUPS, SSD_STATE)
        cm = cm.astype(jnp.float32).reshape(b, s, N_SSD_GROUPS, SSD_STATE)
        dt = jax.nn.softplus(dt_raw.astype(jnp.float32) + dt_bias[i].astype(jnp.float32))
        a = -jnp.exp(a_log[i].astype(jnp.float32))
        y = ssd_scan(xs, dt, a, bm, cm) + d_skip[i].astype(jnp.float32)[:, None] * xs
        y = y.reshape(b, s, SSD_WIDTH) * jax.nn.silu(z.astype(jnp.float32))
        y = rms_norm(y.reshape(b, s, N_SSD_GROUPS, SSD_WIDTH // N_SSD_GROUPS),
                     ssd_norm_w[i].reshape(N_SSD_GROUPS, SSD_WIDTH // N_SSD_GROUPS))
        y = y.reshape(b, s, SSD_WIDTH).astype(x.dtype)

        x = x + jnp.concatenate([o_attn, y], axis=-1) @ w_out[i]

        hm = rms_norm(x, mlp_norm_w[i])
        x = x + jnp.square(jax.nn.relu(hm @ w_up[i])) @ w_down[i]
    return x
```

```cpp
#include <hip/hip_runtime.h>
#include <hip/hip_cooperative_groups.h>
#include <cstdio>
#include <cstdint>
namespace cg = cooperative_groups;
#ifndef MK_REPEAT
#define MK_REPEAT 0
#endif
namespace pg8 {
#define PG8_LAS __attribute__((address_space(3)))
typedef unsigned short bf16_t;
typedef short bf16x8 __attribute__((ext_vector_type(8)));
typedef float f32x4 __attribute__((ext_vector_type(4)));
typedef unsigned u32x4 __attribute__((ext_vector_type(4)));
constexpr int BM = 256, BK = 64, HALF = 128, HTB = HALF * BK * 2  , STAGE_BYTES = 8 * HTB, NXCD = 8, WGM = 8;

__host__ __device__ __forceinline__ int lds_byte(int r, int c) { const int st = (r >> 4) * 2 + (c >> 5), rr = r & 15, cc = c & 31, ob = rr * 64 + cc * 2; return st * 1024 + (ob ^ (((ob >> 9) & 1) << 5)); }
__host__ __device__ __forceinline__ void stage_rc(int b, int& R, int& C) { const int st = b / 1024, sb = b % 1024, swz = sb ^ (((sb >> 9) & 1) << 5); R = (st >> 1) * 16 + swz / 64; C = (st & 1) * 32 + (swz % 64) / 2; }
__host__ __device__ __forceinline__ int perm32(int rho) { const int n = rho >> 4, i = rho & 15; return 8 * (i >> 2) + 4 * n + (i & 3); }

struct Unit { int pm, pn; };
struct Gemm { const bf16_t* A; const bf16_t* Bt; int M, N, K; };

struct StaticOrder {
    int nM, nN, nwg, G, c;
    __host__ __device__ void init(int M, int N, int G_, int c_) { nM = M / BM; nN = N / BM; nwg = nM * nN; G = G_; c = c_; }
    __host__ __device__ bool next(int i, Unit& u) const {
        const long L = (long)i * G + c; if (L >= nwg) return false;
        int wgid = (int)L; { const int q = nwg / NXCD, r = nwg % NXCD, xcd = wgid % NXCD, off = wgid / NXCD; wgid = (xcd < r ? xcd * (q + 1) : r * (q + 1) + (xcd - r) * q) + off; }
        const int nig = WGM * nN, gid = wgid / nig, fm = gid * WGM, gsz = (nM - fm) < WGM ? (nM - fm) : WGM;
        u.pm = fm + ((wgid % nig) % gsz); u.pn = (wgid % nig) / gsz; return true;
    }
    __device__ __forceinline__ void a_ready(const Unit&) const {}
    __device__ __forceinline__ void done(const Unit&) const {}
};


typedef float f32x2_t __attribute__((ext_vector_type(2))); typedef __bf16 bf16x2_t __attribute__((ext_vector_type(2)));
__device__ __forceinline__ unsigned pk2(float lo, float hi) { f32x2_t v = {lo, hi}; bf16x2_t b = __builtin_convertvector(v, bf16x2_t); return __builtin_bit_cast(unsigned, b); }
__device__ __forceinline__ u32x4 pk8(const f32x4 a, const f32x4 b) { u32x4 w; w.x = pk2(a[0], a[1]); w.y = pk2(a[2], a[3]); w.z = pk2(b[0], b[1]); w.w = pk2(b[2], b[3]); return w; }

constexpr float QSCALE = 0.18033688011112042f;
constexpr float NORM_EPS = 1e-6f;
constexpr int PROJ_LD = 3072;

#define EPI_FENCE() asm volatile("" ::: "memory")

struct EpiInProj {
    static constexpr bool PERM = true, AFTER_DRAIN = false;
    bf16_t* P; const float* qw; const float* kw; const float* rc; const float* rs;
    __device__ __forceinline__ void operator()(const f32x4 (&acc)[2][2][4][2], const Unit& u, int wr, int wc, int fr, int fq) const {
        const int row0 = u.pm * BM + wr * 64 + fr, cbase = u.pn * BM + 64 * wc + 8 * fq;
        if (u.pn < 4) {
            const bool isq = u.pn < 2; const float* w = isq ? qw : kw; const float osc = isq ? QSCALE : 1.0f;
            f32x4 wv[2][2];
#pragma unroll
            for (int bj = 0; bj < 2; ++bj)
#pragma unroll
                for (int n = 0; n < 2; ++n) wv[bj][n] = *(const f32x4*)(w + 32 * bj + 8 * fq + 4 * n);
            f32x4 tc[2][2], ts[2][2];
#pragma unroll
            for (int g = 0; g < 2; ++g) { const int t = (row0 + g * 16) & 2047;
#pragma unroll
                for (int n = 0; n < 2; ++n) { tc[g][n] = *(const f32x4*)(rc + t * 32 + 8 * fq + 4 * n); ts[g][n] = *(const f32x4*)(rs + t * 32 + 8 * fq + 4 * n); } }
            EPI_FENCE();
#pragma unroll
            for (int g = 0; g < 8; ++g) {
                const int ai = g >> 2, m = g & 3, row = row0 + ai * HALF + m * 16;
                float ss = 0.f;
#pragma unroll
                for (int bj = 0; bj < 2; ++bj)
#pragma unroll
                    for (int n = 0; n < 2; ++n) { const f32x4 v = acc[ai][bj][m][n]; ss += (v[0] * v[0] + v[1] * v[1]) + (v[2] * v[2] + v[3] * v[3]); }
                ss += __shfl_xor(ss, 16); ss += __shfl_xor(ss, 32);
                const float rstd = rsqrtf(ss * (1.0f / 64.0f) + NORM_EPS);
                f32x4 o1[2], o2[2];
#pragma unroll
                for (int n = 0; n < 2; ++n) {
                    const f32x4 cs = tc[g & 1][n], sn = ts[g & 1][n];
                    const f32x4 x1 = acc[ai][0][m][n] * rstd * wv[0][n], x2 = acc[ai][1][m][n] * rstd * wv[1][n];
                    o1[n] = (x1 * cs - x2 * sn) * osc; o2[n] = (x2 * cs + x1 * sn) * osc;
                }
                bf16_t* rp = P + (size_t)row * PROJ_LD + cbase;
                *(u32x4*)(rp) = pk8(o1[0], o1[1]); *(u32x4*)(rp + 32) = pk8(o2[0], o2[1]);
                if (g + 2 < 8) { const int g2 = g + 2; const int t = (row0 + (g2 >> 2) * HALF + (g2 & 3) * 16) & 2047;
#pragma unroll
                    for (int n = 0; n < 2; ++n) { tc[g & 1][n] = *(const f32x4*)(rc + t * 32 + 8 * fq + 4 * n); ts[g & 1][n] = *(const f32x4*)(rs + t * 32 + 8 * fq + 4 * n); } }
                EPI_FENCE();
            }
        } else {
#pragma unroll
            for (int ai = 0; ai < 2; ++ai)
#pragma unroll
                for (int m = 0; m < 4; ++m) { bf16_t* rp = P + (size_t)(row0 + ai * HALF + m * 16) * PROJ_LD + cbase;
#pragma unroll
                    for (int bj = 0; bj < 2; ++bj) *(u32x4*)(rp + 32 * bj) = pk8(acc[ai][bj][m][0], acc[ai][bj][m][1]); }
        }
    }
};

struct EpiOutProj {
    static constexpr bool PERM = true, AFTER_DRAIN = false;
    const float* x; bf16_t* x1b; float* part;
    __device__ __forceinline__ void operator()(const f32x4 (&acc)[2][2][4][2], const Unit& u, int wr, int wc, int fr, int fq) const {
        const int row0 = u.pm * BM + wr * 64 + fr, c0 = u.pn * BM + wc * 32 + 8 * fq;
        f32x4 pre[4][2][2];
#pragma unroll
        for (int g = 0; g < 4; ++g) { const float* xp = x + (size_t)(row0 + g * 16) * 1024 + c0;
#pragma unroll
            for (int bj = 0; bj < 2; ++bj) { pre[g][bj][0] = *(const f32x4*)(xp + bj * HALF); pre[g][bj][1] = *(const f32x4*)(xp + bj * HALF + 4); } }
        EPI_FENCE();
#pragma unroll
        for (int g = 0; g < 8; ++g) {
            const int ai = g >> 2, m = g & 3, row = row0 + ai * HALF + m * 16; const size_t off = (size_t)row * 1024 + c0; float ss = 0.f;
#pragma unroll
            for (int bj = 0; bj < 2; ++bj) {
                const f32x4 a = acc[ai][bj][m][0] + pre[m][bj][0], b = acc[ai][bj][m][1] + pre[m][bj][1];
                *(u32x4*)(x1b + off + bj * HALF) = pk8(a, b);
                ss += (a[0] * a[0] + a[1] * a[1]) + (a[2] * a[2] + a[3] * a[3]) + (b[0] * b[0] + b[1] * b[1]) + (b[2] * b[2] + b[3] * b[3]);
            }
            if (g + 4 < 8) { const float* xp = x + (size_t)(row0 + HALF + m * 16) * 1024 + c0;
#pragma unroll
                for (int bj = 0; bj < 2; ++bj) { pre[m][bj][0] = *(const f32x4*)(xp + bj * HALF); pre[m][bj][1] = *(const f32x4*)(xp + bj * HALF + 4); } }
            ss += __shfl_xor(ss, 16); ss += __shfl_xor(ss, 32);
            if (fq == 0) part[(size_t)row * 16 + u.pn * 4 + wc] = ss;
            EPI_FENCE();
        }
    }
};

struct EpiUp {
    static constexpr bool PERM = true, AFTER_DRAIN = false;
    bf16_t* act; const float* part;
    __device__ __forceinline__ void operator()(const f32x4 (&acc)[2][2][4][2], const Unit& u, int wr, int wc, int fr, int fq) const {
        const int row0 = u.pm * BM + wr * 64 + fr, c0 = u.pn * BM + wc * 32 + 8 * fq;
        f32x4 pp[8];
#pragma unroll
        for (int g = 0; g < 8; ++g) pp[g] = *(const f32x4*)(part + (size_t)(row0 + (g >> 2) * HALF + (g & 3) * 16) * 16 + 4 * fq);
        EPI_FENCE();
        float rstd[8];
#pragma unroll
        for (int g = 0; g < 8; ++g) { float s = (pp[g][0] + pp[g][1]) + (pp[g][2] + pp[g][3]); s += __shfl_xor(s, 16); s += __shfl_xor(s, 32); rstd[g] = rsqrtf(s * (1.0f / 1024.0f) + NORM_EPS); }
#pragma unroll
        for (int g = 0; g < 8; ++g) {
            const int ai = g >> 2, m = g & 3; bf16_t* rp = act + (size_t)(row0 + ai * HALF + m * 16) * 4096 + c0;
#pragma unroll
            for (int bj = 0; bj < 2; ++bj) {
                f32x4 a = acc[ai][bj][m][0] * rstd[g], b = acc[ai][bj][m][1] * rstd[g];
#pragma unroll
                for (int e = 0; e < 4; ++e) { a[e] = a[e] > 0.f ? a[e] * a[e] : 0.f; b[e] = b[e] > 0.f ? b[e] * b[e] : 0.f; }
                *(u32x4*)(rp + bj * HALF) = pk8(a, b);
            }
        }
    }
};

struct EpiDown {
    static constexpr bool PERM = true, AFTER_DRAIN = false;
    float* out; const bf16_t* x1b;
    __device__ __forceinline__ void operator()(const f32x4 (&acc)[2][2][4][2], const Unit& u, int wr, int wc, int fr, int fq) const {
        const int row0 = u.pm * BM + wr * 64 + fr, c0 = u.pn * BM + wc * 32 + 8 * fq;
        u32x4 pre[8][2];
#pragma unroll
        for (int g = 0; g < 8; ++g) { const bf16_t* xp = x1b + (size_t)(row0 + (g >> 2) * HALF + (g & 3) * 16) * 1024 + c0; pre[g][0] = *(const u32x4*)xp; pre[g][1] = *(const u32x4*)(xp + HALF); }
        EPI_FENCE();
#pragma unroll
        for (int g = 0; g < 8; ++g) {
            const int ai = g >> 2, m = g & 3; const size_t off = (size_t)(row0 + ai * HALF + m * 16) * 1024 + c0;
#pragma unroll
            for (int bj = 0; bj < 2; ++bj) { const u32x4 r = pre[g][bj];
                f32x4 a, b; a[0] = __uint_as_float(r.x << 16); a[1] = __uint_as_float(r.x & 0xffff0000u); a[2] = __uint_as_float(r.y << 16); a[3] = __uint_as_float(r.y & 0xffff0000u);
                b[0] = __uint_as_float(r.z << 16); b[1] = __uint_as_float(r.z & 0xffff0000u); b[2] = __uint_as_float(r.w << 16); b[3] = __uint_as_float(r.w & 0xffff0000u);
                *(f32x4*)(out + off + bj * HALF) = a + acc[ai][bj][m][0]; *(f32x4*)(out + off + bj * HALF + 4) = b + acc[ai][bj][m][1]; }
        }
    }
};


struct EpiUpT {
    static constexpr bool PERM = true, AFTER_DRAIN = false;
    bf16_t* act; const float* part; const PG8_LAS float* rt; int pmc;
    __device__ __forceinline__ void operator()(const f32x4 (&acc)[2][2][4][2], const Unit& u, int wr, int wc, int fr, int fq) const {
        const int row0 = u.pm * BM + wr * 64 + fr, c0 = u.pn * BM + wc * 32 + 8 * fq;
        float rstd[8];
        if (u.pm == pmc) {
#pragma unroll
            for (int g = 0; g < 8; ++g) rstd[g] = rt[(g >> 2) * HALF + wr * 64 + (g & 3) * 16 + fr];
        } else {
            f32x4 pp[8];
#pragma unroll
            for (int g = 0; g < 8; ++g) pp[g] = *(const f32x4*)(part + (size_t)(row0 + (g >> 2) * HALF + (g & 3) * 16) * 16 + 4 * fq);
            EPI_FENCE();
#pragma unroll
            for (int g = 0; g < 8; ++g) { float s = (pp[g][0] + pp[g][1]) + (pp[g][2] + pp[g][3]); s += __shfl_xor(s, 16); s += __shfl_xor(s, 32); rstd[g] = rsqrtf(s * (1.0f / 1024.0f) + NORM_EPS); }
        }
#pragma unroll
        for (int g = 0; g < 8; ++g) {
            const int ai = g >> 2, m = g & 3; bf16_t* rp = act + (size_t)(row0 + ai * HALF + m * 16) * 4096 + c0;
#pragma unroll
            for (int bj = 0; bj < 2; ++bj) {
                f32x4 a = acc[ai][bj][m][0] * rstd[g], b = acc[ai][bj][m][1] * rstd[g];
#pragma unroll
                for (int e = 0; e < 4; ++e) { a[e] = a[e] > 0.f ? a[e] * a[e] : 0.f; b[e] = b[e] > 0.f ? b[e] * b[e] : 0.f; }
                *(u32x4*)(rp + bj * HALF) = pk8(a, b);
            }
        }
    }
};

__device__ __forceinline__ void preload_f32_tile(f32x4 (&acc)[2][2][4][2], const float* x, const Unit& u, int wr, int wc, int fr, int fq) {
    const int row0 = u.pm * BM + wr * 64 + fr, c0 = u.pn * BM + wc * 32 + 8 * fq;
#pragma unroll
    for (int ai = 0; ai < 2; ++ai)
#pragma unroll
        for (int m = 0; m < 4; ++m) { const float* xp = x + (size_t)(row0 + ai * HALF + m * 16) * 1024 + c0;
#pragma unroll
            for (int bj = 0; bj < 2; ++bj) { acc[ai][bj][m][0] = *(const f32x4*)(xp + bj * HALF); acc[ai][bj][m][1] = *(const f32x4*)(xp + bj * HALF + 4); } }
}
__device__ __forceinline__ void preload_bf16_tile(f32x4 (&acc)[2][2][4][2], const bf16_t* xb, const Unit& u, int wr, int wc, int fr, int fq) {
    const int row0 = u.pm * BM + wr * 64 + fr, c0 = u.pn * BM + wc * 32 + 8 * fq;
#pragma unroll
    for (int ai = 0; ai < 2; ++ai)
#pragma unroll
        for (int m = 0; m < 4; ++m) { const bf16_t* xp = xb + (size_t)(row0 + ai * HALF + m * 16) * 1024 + c0;
#pragma unroll
            for (int bj = 0; bj < 2; ++bj) { const u32x4 r = *(const u32x4*)(xp + bj * HALF);
                acc[ai][bj][m][0] = (f32x4){__uint_as_float(r.x << 16), __uint_as_float(r.x & 0xffff0000u), __uint_as_float(r.y << 16), __uint_as_float(r.y & 0xffff0000u)};
                acc[ai][bj][m][1] = (f32x4){__uint_as_float(r.z << 16), __uint_as_float(r.z & 0xffff0000u), __uint_as_float(r.w << 16), __uint_as_float(r.w & 0xffff0000u)}; } }
}

__device__ __forceinline__ void preload_h_tile(f32x4 (&acc)[2][2][4][2], const bf16_t* H, const float* RS, const float* w, const Unit& u, int wr, int wc, int fr, int fq) {
    const int row0 = u.pm * BM + wr * 64 + fr, c0 = u.pn * BM + wc * 32 + 8 * fq;
    u32x4 raw[8][2]; float rs[8];
#pragma unroll
    for (int g = 0; g < 8; ++g) { const int row = row0 + (g >> 2) * HALF + (g & 3) * 16; const bf16_t* hp = H + (size_t)row * 1024 + c0;
        raw[g][0] = *(const u32x4*)hp; raw[g][1] = *(const u32x4*)(hp + HALF); rs[g] = RS[row]; }
    f32x4 iw[2][2];
#pragma unroll
    for (int bj = 0; bj < 2; ++bj)
#pragma unroll
        for (int n = 0; n < 2; ++n) { const f32x4 wv = *(const f32x4*)(w + c0 + bj * HALF + 4 * n); iw[bj][n] = (f32x4){1.0f / wv[0], 1.0f / wv[1], 1.0f / wv[2], 1.0f / wv[3]}; }
#pragma unroll
    for (int g = 0; g < 8; ++g) { const int ai = g >> 2, m = g & 3; const float ir = 1.0f / rs[g];
#pragma unroll
        for (int bj = 0; bj < 2; ++bj) { const u32x4 r = raw[g][bj];
            acc[ai][bj][m][0] = (f32x4){__uint_as_float(r.x << 16), __uint_as_float(r.x & 0xffff0000u), __uint_as_float(r.y << 16), __uint_as_float(r.y & 0xffff0000u)} * ir * iw[bj][0];
            acc[ai][bj][m][1] = (f32x4){__uint_as_float(r.z << 16), __uint_as_float(r.z & 0xffff0000u), __uint_as_float(r.w << 16), __uint_as_float(r.w & 0xffff0000u)} * ir * iw[bj][1]; } }
}
struct EpiOutProjPre {
    static constexpr bool PERM = true, AFTER_DRAIN = false;
    bf16_t* x1b; float* part;
    __device__ __forceinline__ void operator()(const f32x4 (&acc)[2][2][4][2], const Unit& u, int wr, int wc, int fr, int fq) const {
        const int row0 = u.pm * BM + wr * 64 + fr, c0 = u.pn * BM + wc * 32 + 8 * fq;
#pragma unroll
        for (int g = 0; g < 8; ++g) {
            const int ai = g >> 2, m = g & 3, row = row0 + ai * HALF + m * 16; const size_t off = (size_t)row * 1024 + c0; float ss = 0.f;
#pragma unroll
            for (int bj = 0; bj < 2; ++bj) { const f32x4 a = acc[ai][bj][m][0], b = acc[ai][bj][m][1];
                *(u32x4*)(x1b + off + bj * HALF) = pk8(a, b);
                ss += (a[0] * a[0] + a[1] * a[1]) + (a[2] * a[2] + a[3] * a[3]) + (b[0] * b[0] + b[1] * b[1]) + (b[2] * b[2] + b[3] * b[3]); }
            ss += __shfl_xor(ss, 16); ss += __shfl_xor(ss, 32);
            if (fq == 0) part[(size_t)row * 16 + u.pn * 4 + wc] = ss;
        }
    }
};
struct EpiDownPre {
    static constexpr bool PERM = true, AFTER_DRAIN = false;
    float* out;
    __device__ __forceinline__ void operator()(const f32x4 (&acc)[2][2][4][2], const Unit& u, int wr, int wc, int fr, int fq) const {
        const int row0 = u.pm * BM + wr * 64 + fr, c0 = u.pn * BM + wc * 32 + 8 * fq;
#pragma unroll
        for (int ai = 0; ai < 2; ++ai)
#pragma unroll
            for (int m = 0; m < 4; ++m) { float* rp = out + (size_t)(row0 + ai * HALF + m * 16) * 1024 + c0;
#pragma unroll
                for (int bj = 0; bj < 2; ++bj) { *(f32x4*)(rp + bj * HALF) = acc[ai][bj][m][0]; *(f32x4*)(rp + bj * HALF + 4) = acc[ai][bj][m][1]; } }
    }
};

template <class Epi, class Sched, bool ALIGN_EPI = false, bool SP2 = false, bool PRELOADED = false>
__device__ __forceinline__ void gemm_phase(PG8_LAS unsigned char* lds, const Gemm g, const Sched& S, const Epi& E, f32x4 (&acc)[2][2][4][2]) {
    const int tid = threadIdx.x, wid = __builtin_amdgcn_readfirstlane(tid >> 6), lane = tid & 63, wr = wid >> 2, wc = wid & 3, fr = lane & 15, fq = lane >> 4;
    const int K = g.K, nt = K / BK;
    unsigned voffA[2], voffB[2];
#pragma unroll
    for (int i = 0; i < 2; ++i) { int R, C; stage_rc(tid * 16 + i * 8192, R, C); const int Rb = Epi::PERM ? ((R & ~31) + perm32(R & 31)) : R;
        voffA[i] = (unsigned)(R * K + C) * 2u; voffB[i] = (unsigned)(Rb * K + C) * 2u; }
    const size_t kstep = (size_t)(BK * 2);
    const size_t hstep = (size_t)HALF * K * 2;
    const size_t tstep = 2 * hstep;
    const unsigned ldsw = (unsigned)wid * 1024u;
    const int aoff = lds_byte(wr * 64 + fr, fq * 8), boff = lds_byte(wc * 32 + fr, fq * 8);
#define PG8_SA(b, h) (((b) * 2 + (h)) * HTB)
#define PG8_SB(b, h) ((4 + (b) * 2 + (h)) * HTB)
#define PG8_STAGE(bufoff, gbase, voff) do { _Pragma("unroll") for (int _i = 0; _i < 2; ++_i) \
        __builtin_amdgcn_global_load_lds((const unsigned*)((const char*)(gbase) + (voff)[_i]), (PG8_LAS unsigned*)(lds + (bufoff) + ldsw + _i * 8192), 16, 0, 0); } while (0)
#define PG8_LDA(dst, b, h) do { _Pragma("unroll") for (int m = 0; m < 4; ++m) _Pragma("unroll") for (int k = 0; k < 2; ++k) dst[m][k] = *(const PG8_LAS bf16x8*)(lds + PG8_SA(b, h) + aoff + m * 2048 + k * 1024); } while (0)
#define PG8_LDB(dst, b, h) do { _Pragma("unroll") for (int n = 0; n < 2; ++n) _Pragma("unroll") for (int k = 0; k < 2; ++k) dst[n][k] = *(const PG8_LAS bf16x8*)(lds + PG8_SB(b, h) + boff + n * 2048 + k * 1024); } while (0)
#define PG8_MMA(ai, bj, At, Bt) do { __builtin_amdgcn_s_setprio(1); _Pragma("unroll") for (int m = 0; m < 4; ++m) _Pragma("unroll") for (int n = 0; n < 2; ++n) _Pragma("unroll") for (int k = 0; k < 2; ++k) \
        acc[ai][bj][m][n] = __builtin_amdgcn_mfma_f32_16x16x32_bf16(Bt[n][k], At[m][k], acc[ai][bj][m][n], 0, 0, 0); __builtin_amdgcn_s_setprio(0); } while (0)
#define PG8_WAIT_V(n) asm volatile("s_waitcnt vmcnt(" #n ")" ::: "memory")
#define PG8_WAIT_L(n) asm volatile("s_waitcnt lgkmcnt(" #n ")" ::: "memory")
#define PG8_BAR __builtin_amdgcn_s_barrier()
#define PG8_SCHED __builtin_amdgcn_sched_barrier(0)
    Unit cur, nxt; int ui = 0;
    if (!S.next(0, cur)) return;
    if constexpr (!PRELOADED) {
#pragma unroll
    for (int a = 0; a < 2; ++a)
#pragma unroll
        for (int b = 0; b < 2; ++b)
#pragma unroll
            for (int m = 0; m < 4; ++m)
#pragma unroll
                for (int n = 0; n < 2; ++n) acc[a][b][m][n] = (f32x4){0.f, 0.f, 0.f, 0.f};
    }
    bf16x8 At[4][2], B0[2][2], B1[2][2];
    const char* cA = (const char*)g.A + (size_t)cur.pm * tstep; const char* cB = (const char*)g.Bt + (size_t)cur.pn * tstep;
    S.a_ready(cur);
    if constexpr (SP2) {
        PG8_STAGE(PG8_SB(0, 0), cB, voffB); PG8_STAGE(PG8_SB(0, 1), cB + hstep, voffB); PG8_STAGE(PG8_SA(0, 0), cA, voffA); PG8_STAGE(PG8_SA(0, 1), cA + hstep, voffA);
        if (wr == 1) PG8_BAR;
        PG8_WAIT_V(2); PG8_BAR;
        PG8_STAGE(PG8_SB(1, 0), cB + kstep, voffB); PG8_STAGE(PG8_SA(1, 0), cA + kstep, voffA); PG8_STAGE(PG8_SB(1, 1), cB + hstep + kstep, voffB);
        PG8_WAIT_V(6); PG8_BAR;
    } else {
        PG8_STAGE(PG8_SB(0, 0), cB, voffB); PG8_STAGE(PG8_SA(0, 0), cA, voffA); PG8_STAGE(PG8_SB(0, 1), cB + hstep, voffB); PG8_STAGE(PG8_SA(0, 1), cA + hstep, voffA);
        if (wr == 1) PG8_BAR;
        PG8_WAIT_V(4); PG8_BAR;
        PG8_STAGE(PG8_SB(1, 0), cB + kstep, voffB); PG8_STAGE(PG8_SA(1, 0), cA + kstep, voffA); PG8_STAGE(PG8_SB(1, 1), cB + hstep + kstep, voffB);
        PG8_WAIT_V(6); PG8_BAR;
    }
    for (;;) {
        const bool has_next = S.next(ui + 1, nxt);
        const char* nA = has_next ? (const char*)g.A + (size_t)nxt.pm * tstep : cA; const char* nB = has_next ? (const char*)g.Bt + (size_t)nxt.pn * tstep : cB;
        for (int t = 0; t < nt; t += 2) {
            const bool last = (t == nt - 2);
            const char* a1 = cA + (size_t)(t + 1) * kstep;
            const char* a2 = last ? nA : cA + (size_t)(t + 2) * kstep; const char* b2 = last ? nB : cB + (size_t)(t + 2) * kstep;
            const char* a3 = a2 + kstep; const char* b3 = b2 + kstep;
            if (last && has_next) S.a_ready(nxt);
            if constexpr (SP2) {
            PG8_LDB(B0, 0, 0); PG8_LDB(B1, 0, 1); PG8_SCHED; PG8_LDA(At, 0, 0); PG8_STAGE(PG8_SA(1, 1), a1 + hstep, voffA);
            PG8_WAIT_V(8); PG8_WAIT_L(0); PG8_BAR; PG8_MMA(0, 0, At, B0); PG8_MMA(0, 1, At, B1); PG8_BAR; PG8_SCHED;
            PG8_LDA(At, 0, 1); PG8_STAGE(PG8_SB(0, 0), b2, voffB); PG8_STAGE(PG8_SB(0, 1), b2 + hstep, voffB); PG8_STAGE(PG8_SA(0, 0), a2, voffA);
            PG8_WAIT_V(8); PG8_WAIT_L(0); PG8_BAR; PG8_MMA(1, 0, At, B0); PG8_MMA(1, 1, At, B1); PG8_BAR; PG8_SCHED;
            PG8_LDB(B0, 1, 0); PG8_LDB(B1, 1, 1); PG8_SCHED; PG8_LDA(At, 1, 0); PG8_STAGE(PG8_SA(0, 1), a2 + hstep, voffA);
            PG8_WAIT_V(8); PG8_WAIT_L(0); PG8_BAR; PG8_MMA(0, 0, At, B0); PG8_MMA(0, 1, At, B1); PG8_BAR; PG8_SCHED;
            PG8_LDA(At, 1, 1); PG8_STAGE(PG8_SB(1, 0), b3, voffB); PG8_STAGE(PG8_SB(1, 1), b3 + hstep, voffB); PG8_STAGE(PG8_SA(1, 0), a3, voffA);
            PG8_WAIT_V(8); PG8_WAIT_L(0); PG8_BAR; PG8_MMA(1, 0, At, B0); PG8_MMA(1, 1, At, B1); PG8_BAR; PG8_SCHED;
            } else {
            PG8_LDB(B0, 0, 0); PG8_SCHED; PG8_LDA(At, 0, 0); PG8_STAGE(PG8_SA(1, 1), a1 + hstep, voffA);
            PG8_WAIT_L(8); PG8_BAR; PG8_WAIT_L(0); PG8_MMA(0, 0, At, B0); PG8_BAR; PG8_SCHED;
            PG8_LDB(B1, 0, 1); PG8_STAGE(PG8_SB(0, 0), b2, voffB);
            PG8_BAR; PG8_WAIT_L(0); PG8_MMA(0, 1, At, B1); PG8_BAR;
            PG8_LDA(At, 0, 1); PG8_STAGE(PG8_SA(0, 0), a2, voffA);
            PG8_BAR; PG8_WAIT_L(0); PG8_MMA(1, 0, At, B0); PG8_BAR; PG8_SCHED;
            PG8_STAGE(PG8_SB(0, 1), b2 + hstep, voffB);
            PG8_WAIT_V(6); PG8_BAR; PG8_MMA(1, 1, At, B1); PG8_BAR;
            PG8_LDB(B0, 1, 0); PG8_SCHED; PG8_LDA(At, 1, 0); PG8_STAGE(PG8_SA(0, 1), a2 + hstep, voffA);
            PG8_WAIT_L(8); PG8_BAR; PG8_WAIT_L(0); PG8_MMA(0, 0, At, B0); PG8_BAR; PG8_SCHED;
            PG8_LDB(B1, 1, 1); PG8_STAGE(PG8_SB(1, 0), b3, voffB);
            PG8_BAR; PG8_WAIT_L(0); PG8_MMA(0, 1, At, B1); PG8_BAR;
            PG8_LDA(At, 1, 1); PG8_STAGE(PG8_SA(1, 0), a3, voffA);
            PG8_BAR; PG8_WAIT_L(0); PG8_MMA(1, 0, At, B0); PG8_BAR; PG8_SCHED;
            PG8_STAGE(PG8_SB(1, 1), b3 + hstep, voffB);
            PG8_WAIT_V(6); PG8_BAR; PG8_MMA(1, 1, At, B1); PG8_BAR;
            }
        }
        if constexpr (ALIGN_EPI) { if (wr == 0) PG8_BAR; }
        if constexpr (!Epi::AFTER_DRAIN) { E(acc, cur, wr, wc, fr, fq); S.done(cur); }
        if (!has_next) break;
#pragma unroll
        for (int a = 0; a < 2; ++a)
#pragma unroll
            for (int b = 0; b < 2; ++b)
#pragma unroll
                for (int m = 0; m < 4; ++m)
#pragma unroll
                    for (int n = 0; n < 2; ++n) acc[a][b][m][n] = (f32x4){0.f, 0.f, 0.f, 0.f};
        cur = nxt; cA = nA; cB = nB; ++ui;
        if constexpr (ALIGN_EPI) { if (wr == 1) PG8_BAR; }
    }
    PG8_WAIT_V(0);
    if constexpr (!ALIGN_EPI) { if (wr == 0) PG8_BAR; }
    PG8_BAR;
    if constexpr (Epi::AFTER_DRAIN) { E.fused(acc, cur, wr, wc, fr, fq, lds, wid, lane); S.done(cur); }
#undef PG8_SA
#undef PG8_SB
#undef PG8_STAGE
#undef PG8_LDA
#undef PG8_LDB
#undef PG8_MMA
#undef PG8_WAIT_V
#undef PG8_WAIT_L
#undef PG8_BAR
#undef PG8_SCHED
}
}

#define LAS __attribute__((address_space(3)))
typedef unsigned short bf16_t;
typedef short bf16x8 __attribute__((ext_vector_type(8)));
typedef short s16x4 __attribute__((ext_vector_type(4)));
typedef float f32x4 __attribute__((ext_vector_type(4)));
typedef float f32x16 __attribute__((ext_vector_type(16)));
typedef unsigned u32x4 __attribute__((ext_vector_type(4)));
typedef unsigned u32x2 __attribute__((ext_vector_type(2)));
using pg8::pk2;

constexpr int M = 16384, D = 1024, SEQ = 2048, FF = 4096, NPROJ = 3072, INW = 3080;
constexpr size_t MiB = 1u << 20;
constexpr size_t WS_WIN = 0, WS_WOUT = 6 * MiB, WS_WUP = 8 * MiB, WS_WDOWN = 16 * MiB, WS_ROPE = 24 * MiB, WS_DT = WS_ROPE + 512 * 1024, WS_ACS = 25 * MiB,
                 WS_PART = WS_ACS + 512 * 1024, WS_LP = WS_PART + MiB, WS_MIX = 28 * MiB, WS_CS = 60 * MiB, WS_X1B = 60 * MiB, WS_SIN = 92 * MiB,
                 WS_BIG = 108 * MiB, WS_H = WS_BIG, WS_XBCC = WS_BIG, WS_PROJ = WS_BIG + 32 * MiB, WS_ACT = WS_BIG, WS_CC = 236 * MiB  , WS_RS = 244 * MiB  , WS_BAR = 245 * MiB  , WS_END = 246 * MiB;
constexpr int LDS_BYTES = 143360;
constexpr int NPHASE = 8;
#ifndef MK_SPLIT
#define MK_SPLIT 0
#endif

#define REP(k) for (int rep_ = 0; rep_ < 1 + ((MK_REPEAT >> (k)) & 1); ++rep_)
#define LDS_WAIT() asm volatile("s_waitcnt lgkmcnt(0)" ::: "memory")
#define LDS_BARRIER() do { asm volatile("s_waitcnt lgkmcnt(0)" ::: "memory"); __builtin_amdgcn_s_barrier(); asm volatile("" ::: "memory"); } while (0)
__device__ __forceinline__ float bflo(unsigned w) { return __uint_as_float(w << 16); }
__device__ __forceinline__ float bfhi(unsigned w) { return __uint_as_float(w & 0xffff0000u); }
__device__ __forceinline__ float wave_sum(float v) {
#pragma unroll
    for (int o = 1; o < 64; o <<= 1) v += __shfl_xor(v, o);
    return v;
}
__device__ __forceinline__ f32x16 mfma32(bf16x8 a, bf16x8 b, f32x16 c) { return __builtin_amdgcn_mfma_f32_32x32x16_bf16(a, b, c, 0, 0, 0); }
__device__ __forceinline__ s16x4 trd(const LAS unsigned char* p) { return __builtin_bit_cast(s16x4, __builtin_amdgcn_ds_read_tr16_b64_v4i16((LAS s16x4*)p)); }
__device__ __forceinline__ bf16x8 cat8(s16x4 lo, s16x4 hi) { return (bf16x8){lo[0], lo[1], lo[2], lo[3], hi[0], hi[1], hi[2], hi[3]}; }
__device__ __forceinline__ float silu_f(float v) { return v / (1.0f + __expf(-v)); }

#define XB_TMO      128
#define XB_XCNT(j)  (256  + 64 * (j))
#define XB_XSUB(j)  (1280 + 64 * (j))
#define XB_XGEN(j)  (2304 + 64 * (j))
#define XB_TOP      3328
#define XB_TOPGEN   3392
#define XCD_BAR_WORDS 3456
#define XB_SPIN_CAP (1u << 18)

__device__ __forceinline__ unsigned xb_ld(unsigned* p)              { return __hip_atomic_load(p, __ATOMIC_RELAXED, __HIP_MEMORY_SCOPE_AGENT); }
__device__ __forceinline__ unsigned xb_add(unsigned* p, unsigned v) { return __hip_atomic_fetch_add(p, v, __ATOMIC_RELAXED, __HIP_MEMORY_SCOPE_AGENT); }
__device__ __forceinline__ unsigned xb_xcc_id() { return (unsigned)__builtin_amdgcn_s_getreg((3 << 11) | 20) & 0xFu; }
#define XB_SPIN(cond, bar) do { unsigned _sp = 0; while (cond) { __builtin_amdgcn_s_sleep(1); \
    if ((++_sp & 255u) == 0u) { if (xb_ld(&(bar)[XB_TMO])) break; if (_sp > XB_SPIN_CAP) { atomicAdd(&(bar)[XB_TMO], 1u); break; } } } } while (0)

struct XcdBarrier {
    unsigned* bar; unsigned x;
    volatile LAS unsigned* st;
};

__device__ __forceinline__ XcdBarrier xcd_barrier_post(unsigned* bar, volatile LAS unsigned* st) {
    XcdBarrier b; b.bar = bar; b.x = xb_xcc_id(); b.st = st;
    if (threadIdx.x == 0) (void)xb_add(&bar[XB_XCNT(b.x)], 1u);
    return b;
}
__device__ __forceinline__ void xcd_barrier_complete(unsigned* bar, unsigned x, unsigned& nloc, unsigned& nx) {
    const unsigned G = gridDim.x * gridDim.y * gridDim.z;
    unsigned sum, cnt, mine, sp = 0u;
    for (;;) {
        sum = 0u; cnt = 0u; mine = 0u;
#pragma unroll
        for (unsigned j = 0; j < 16; ++j) { const unsigned c = xb_ld(&bar[XB_XCNT(j)]); sum += c; cnt += (c > 0u) ? 1u : 0u; mine = (j == x) ? c : mine; }
        if (sum == G) break;
        __builtin_amdgcn_s_sleep(1);
        if ((++sp & 255u) == 0u) { if (xb_ld(&bar[XB_TMO])) break; if (sp > XB_SPIN_CAP) { atomicAdd(&bar[XB_TMO], 1u); break; } }
    }
    nloc = mine > 0u ? mine : 1u; nx = cnt > 0u ? cnt : 1u;
}

__device__ __forceinline__ void xcd_barrier_leader(const XcdBarrier& b) {
        unsigned* bar = b.bar;
        __builtin_amdgcn_s_waitcnt(0);
        unsigned nloc = b.st[0], nx = b.st[1];
        if (nloc == 0u) { xcd_barrier_complete(bar, b.x, nloc, nx); b.st[0] = nloc; b.st[1] = nx; }
        const unsigned old = xb_add(&bar[XB_XSUB(b.x)], 1u);
        const unsigned gen = old / nloc;
        if (old + 1u == (gen + 1u) * nloc) {
            __builtin_amdgcn_fence(__ATOMIC_RELEASE, "agent");
            asm volatile("s_waitcnt vmcnt(0)" ::: "memory");
            const unsigned og = xb_add(&bar[XB_TOP], 1u);
            const unsigned tg = og / nx;
            if (og + 1u == (tg + 1u) * nx) xb_add(&bar[XB_TOPGEN], 1u);
            else XB_SPIN(xb_ld(&bar[XB_TOPGEN]) == tg, bar);
            __builtin_amdgcn_fence(__ATOMIC_ACQUIRE, "agent");
            xb_add(&bar[XB_XGEN(b.x)], 1u);
            asm volatile("s_waitcnt vmcnt(0)" ::: "memory");
        } else {
            XB_SPIN(xb_ld(&bar[XB_XGEN(b.x)]) == gen, bar);
            __builtin_amdgcn_fence(__ATOMIC_ACQUIRE, "agent");
            asm volatile("s_waitcnt vmcnt(0)" ::: "memory");
        }
}
__device__ __forceinline__ void xcd_barrier(const XcdBarrier& b) {
    asm volatile("s_waitcnt vmcnt(0)" ::: "memory");
    __syncthreads();
    if (threadIdx.x == 0) xcd_barrier_leader(b);
    __syncthreads();
}


struct Ctx {
    const float *x, *attn_norm_w, *w_in, *q_norm_w, *k_norm_w, *conv_w, *conv_b, *dt_bias, *a_log, *d_skip, *ssd_norm_w, *w_out, *mlp_norm_w, *w_up, *w_down;
    float* out; unsigned char* ws;
    bf16_t *Win, *Wout, *Wup, *Wdown, *H, *XBCC, *PROJ, *ACT, *MIX, *X1B, *SIN, *OP;
    float *ROPEC, *ROPES, *DT, *ACS, *PART, *LP, *RS; bf16_t *CS, *CC;
    LAS unsigned char* lds; int tid, lane, wave, G;
};

__device__ __forceinline__ void p0_transpose_tile(const Ctx& F, const float* W, int ldn, int K, bf16_t* WT, int k0, int n0, int ncols, bool perm, const float* kscale) {
    LAS float* tile = (LAS float*)F.lds;
    f32x4 tv[8];
#pragma unroll
    for (int i = 0; i < 8; ++i) tv[i] = (4 * F.lane < ncols) ? *(const f32x4*)(W + (size_t)(k0 + F.wave * 8 + i) * ldn + n0 + 4 * F.lane) : (f32x4){0.f, 0.f, 0.f, 0.f};
    if (kscale) {
#pragma unroll
        for (int i = 0; i < 8; ++i) tv[i] = tv[i] * kscale[k0 + F.wave * 8 + i]; }
#pragma unroll
    for (int i = 0; i < 8; ++i) *(LAS f32x4*)(tile + (F.wave * 8 + i) * 260 + 4 * F.lane) = tv[i];
    LDS_BARRIER();
#pragma unroll
    for (int j = 0; j < 4; ++j) { const int n = F.lane + 64 * j; if (n < ncols) { const LAS float* sp = tile + (8 * F.wave) * 260 + n;
        u32x4 o; o.x = pk2(sp[0 * 260], sp[1 * 260]); o.y = pk2(sp[2 * 260], sp[3 * 260]); o.z = pk2(sp[4 * 260], sp[5 * 260]); o.w = pk2(sp[6 * 260], sp[7 * 260]);
        const int ng = n0 + n; const int orow = perm ? ((ng & ~255) + 128 * ((ng >> 5) & 1) + 32 * ((ng >> 6) & 3) + (ng & 31)) : ng;
        *(u32x4*)(WT + (size_t)orow * K + k0 + 8 * F.wave) = o; } }
    LDS_BARRIER();
}

__device__ __forceinline__ void p0_transpose_item(const float* W, int ldn, int K, bf16_t* WT, int out_row0, int k0, int n0, const float* kscale, LAS float* scr, int lane) {
    float tv[32];
#pragma unroll
    for (int i = 0; i < 32; ++i) { const int kk = 2 * i + (lane >> 5); tv[i] = W[(size_t)(k0 + kk) * ldn + n0 + (lane & 31)]; }
    if (kscale) {
#pragma unroll
        for (int i = 0; i < 32; ++i) tv[i] *= kscale[k0 + 2 * i + (lane >> 5)]; }
#pragma unroll
    for (int i = 0; i < 32; ++i) scr[(2 * i + (lane >> 5)) * 33 + (lane & 31)] = tv[i];
    LDS_WAIT();
    const int c = lane & 7;
#pragma unroll
    for (int j = 0; j < 4; ++j) { const int n = (lane >> 3) + 8 * j; const LAS float* s = scr + (8 * c) * 33 + n;
        u32x4 o; o.x = pk2(s[0 * 33], s[1 * 33]); o.y = pk2(s[2 * 33], s[3 * 33]); o.z = pk2(s[4 * 33], s[5 * 33]); o.w = pk2(s[6 * 33], s[7 * 33]);
        *(u32x4*)(WT + (size_t)(out_row0 + n) * K + k0 + 8 * c) = o; }
    LDS_WAIT();
}


constexpr int SH_OUT = 16 * 32, SH_UP = 16 * 128, SH_DOWN = 64 * 32, SH_ITEMS = SH_OUT + SH_UP + SH_DOWN, SH_PER_SEAM = SH_ITEMS / 3;
__device__ __forceinline__ void shadow_weight_item(const Ctx& F, int it) {
    LAS float* scr = (LAS float*)(F.lds + F.wave * 8448);
    int r = it;
    if (r < SH_OUT) { const int kb = r / 32, nb = r % 32; p0_transpose_item(F.w_out, D, D, F.Wout, 32 * nb, 64 * kb, 32 * nb, nullptr, scr, F.lane); return; }
    r -= SH_OUT;
    if (r < SH_UP) { const int kb = r / 128, nb = r % 128; p0_transpose_item(F.w_up, FF, D, F.Wup, 32 * nb, 64 * kb, 32 * nb, F.mlp_norm_w, scr, F.lane); return; }
    r -= SH_UP;
    { const int kb = r / 32, nb = r % 32; p0_transpose_item(F.w_down, D, FF, F.Wdown, 32 * nb, 64 * kb, 32 * nb, nullptr, scr, F.lane); }
}
__device__ __forceinline__ void shadow_weights(const Ctx& F, int seam) {
    if (F.wave == 0) return;
    const int nsw = F.G * 7;
    for (int i = blockIdx.x * 7 + (F.wave - 1); i < SH_PER_SEAM; i += nsw) shadow_weight_item(F, seam * SH_PER_SEAM + i);
}

__device__ __forceinline__ void p0_prologue(const Ctx& F) {
    const int gw = blockIdx.x * 8 + F.wave, NGW = F.G * 8;
    constexpr int I_IN = 16 * 16;
    for (int it = blockIdx.x; it < I_IN; it += F.G) p0_transpose_tile(F, F.w_in, INW, D, F.Win, 64 * (it / 16), 192 * (it % 16), 192, true, nullptr);
    for (int idx = blockIdx.x * 512 + F.tid; idx < SEQ * 32; idx += F.G * 512) {
        const int t = idx >> 5, d = idx & 31;
        double p = 1.0; for (int i = 0; i < d; ++i) p *= 0.74989420933245582730;
        const float invf = (float)p, ang = (float)t * invf;
        const double r = (double)ang, k = __builtin_rint(r * 0.63661977236758134308);
        double rr = __builtin_fma(-k, 1.57079632679489655800, r); rr = __builtin_fma(-k, 6.123233995736766036e-17, rr);
        const double r2 = rr * rr;
        const double sp = rr * (1.0 + r2 * (-1.0 / 6 + r2 * (1.0 / 120 + r2 * (-1.0 / 5040 + r2 * (1.0 / 362880 + r2 * (-1.0 / 39916800 + r2 * (1.0 / 6227020800.0)))))));
        const double cp = 1.0 + r2 * (-0.5 + r2 * (1.0 / 24 + r2 * (-1.0 / 720 + r2 * (1.0 / 40320 + r2 * (-1.0 / 3628800 + r2 * (1.0 / 479001600.0 + r2 * (-1.0 / 87178291200.0)))))));
        const int qd = ((int)k) & 3;
        const double sv = (qd == 0) ? sp : (qd == 1) ? cp : (qd == 2) ? -sp : -cp;
        const double cv = (qd == 0) ? cp : (qd == 1) ? -sp : (qd == 2) ? -cp : sp;
        F.ROPEC[idx] = (float)cv; F.ROPES[idx] = (float)sv;
    }
    REP(9) {
        f32x4 wd[4][4][2];
#pragma unroll
        for (int j = 0; j < 4; ++j)
#pragma unroll
            for (int e = 0; e < 4; ++e) { const float* wp = F.w_in + (size_t)(4 * F.lane + 256 * j + e) * INW + NPROJ; wd[j][e][0] = *(const f32x4*)wp; wd[j][e][1] = *(const f32x4*)(wp + 4); }
        const int qsel = 4 * (F.lane & 1) + 2 * ((F.lane >> 1) & 1) + ((F.lane >> 2) & 1);
        const float dtb = F.dt_bias[qsel];
        f32x4 v[4];
        if (gw < M) {
#pragma unroll
            for (int j = 0; j < 4; ++j) v[j] = ((const f32x4*)(F.x + (size_t)gw * D))[F.lane + 64 * j]; }
        for (int m = gw; m < M; m += NGW) {
            f32x4 vn[4]; const int mn = (m + NGW < M) ? m + NGW : m;
#pragma unroll
            for (int j = 0; j < 4; ++j) vn[j] = ((const f32x4*)(F.x + (size_t)mn * D))[F.lane + 64 * j];
            float ss = 0.f;
#pragma unroll
            for (int j = 0; j < 4; ++j) ss += (v[j][0] * v[j][0] + v[j][1] * v[j][1]) + (v[j][2] * v[j][2] + v[j][3] * v[j][3]);
            const float rstd = rsqrtf(wave_sum(ss) * (1.0f / D) + 1e-6f);
            if (F.lane == 0) F.RS[m] = rstd;
            typedef float f32x2v __attribute__((ext_vector_type(2)));
            f32x2v ac2[4];
#pragma unroll
            for (int q = 0; q < 4; ++q) ac2[q] = (f32x2v){0.f, 0.f};
            u32x2* o8 = (u32x2*)(F.H + (size_t)m * D) + F.lane;
#pragma unroll
            for (int j = 0; j < 4; ++j) {
                const f32x4 h = v[j] * rstd * ((const f32x4*)F.attn_norm_w)[F.lane + 64 * j];
                u32x2 o; o.x = pk2(h[0], h[1]); o.y = pk2(h[2], h[3]); o8[64 * j] = o;
#pragma unroll
                for (int e = 0; e < 4; ++e) { const f32x4 w0 = wd[j][e][0], w1 = wd[j][e][1]; const f32x2v hh2 = (f32x2v){h[e], h[e]};
                    ac2[0] += hh2 * (f32x2v){w0[0], w0[1]}; ac2[1] += hh2 * (f32x2v){w0[2], w0[3]};
                    ac2[2] += hh2 * (f32x2v){w1[0], w1[1]}; ac2[3] += hh2 * (f32x2v){w1[2], w1[3]}; }
            }
            const float acc[8] = {ac2[0][0], ac2[0][1], ac2[1][0], ac2[1][1], ac2[2][0], ac2[2][1], ac2[3][0], ac2[3][1]};
            float t4[4], t2[2], t1;
            { const bool b = (F.lane & 1) != 0;
#pragma unroll
              for (int i = 0; i < 4; ++i) { const float send = b ? acc[i] : acc[i + 4], keep = b ? acc[i + 4] : acc[i]; t4[i] = keep + __shfl_xor(send, 1); } }
            { const bool b = (F.lane & 2) != 0;
#pragma unroll
              for (int i = 0; i < 2; ++i) { const float send = b ? t4[i] : t4[i + 2], keep = b ? t4[i + 2] : t4[i]; t2[i] = keep + __shfl_xor(send, 2); } }
            { const bool b = (F.lane & 4) != 0; const float send = b ? t2[0] : t2[1], keep = b ? t2[1] : t2[0]; t1 = keep + __shfl_xor(send, 4); }
            t1 += __shfl_xor(t1, 8); t1 += __shfl_xor(t1, 16); t1 += __shfl_xor(t1, 32);
            if (F.lane < 8) { const float z = t1 + dtb; const float sp = (z > 20.f) ? z : log1pf(__expf(z)); F.DT[(size_t)m * 8 + qsel] = sp; }
#pragma unroll
            for (int j = 0; j < 4; ++j) v[j] = vn[j];
        }
    }
}

__device__ __forceinline__ void ssda_unit(const Ctx& F, int u) {
    const int g = u & 1, c = (u >> 1) & 15, b = u >> 5; const size_t row0 = (size_t)b * SEQ + c * 128;
    LAS unsigned char* lds = F.lds; const int lane = F.lane;
    LAS unsigned char* bimg = lds + 65536; LAS unsigned char* cimg = lds + 100352;
    LAS float* acs = (LAS float*)(lds + 135168); LAS float* dtl = (LAS float*)(lds + 137216); LAS float* dec = (LAS float*)(lds + 139264);
    if (F.wave < 4) {
        const int head = 4 * g + F.wave; const float a = -__expf(F.a_log[head]); const int l0 = 2 * lane;
        const float d0 = F.DT[(row0 + l0) * 8 + head], d1 = F.DT[(row0 + l0 + 1) * 8 + head]; const float a0 = a * d0, a1 = a * d1; float v = a0 + a1;
#pragma unroll
        for (int o = 1; o < 64; o <<= 1) { const float t = __shfl_up(v, o); if (lane >= o) v += t; }
        const float aend = __shfl(v, 63);
        acs[F.wave * 128 + l0] = v - a1; acs[F.wave * 128 + l0 + 1] = v; dtl[F.wave * 128 + l0] = d0; dtl[F.wave * 128 + l0 + 1] = d1;
        dec[F.wave * 128 + l0] = __expf(aend - (v - a1)); dec[F.wave * 128 + l0 + 1] = __expf(aend - v);
        F.ACS[(row0 + l0) * 8 + head] = v - a1; F.ACS[(row0 + l0 + 1) * 8 + head] = v;
    }
    LDS_BARRIER();
    {
        const int cg8 = F.tid & 63, tg = F.tid >> 6;
        const int ch = cg8 < 32 ? 256 * g + 8 * cg8 : (cg8 < 48 ? 512 + 128 * g + 8 * (cg8 - 32) : 768 + 128 * g + 8 * (cg8 - 48));
        float w0[8], w1[8], w2[8], w3[8], bs[8], u0[8], u1[8], u2[8];
#pragma unroll
        for (int e = 0; e < 8; ++e) { w0[e] = F.conv_w[ch + e]; w1[e] = F.conv_w[1024 + ch + e]; w2[e] = F.conv_w[2048 + ch + e]; w3[e] = F.conv_w[3072 + ch + e]; bs[e] = F.conv_b[ch + e]; }
        const int t0 = c * 128 + 16 * tg;
        const bf16_t* src = F.PROJ + (size_t)b * SEQ * NPROJ + 2048 + ch;
#define CVTROW(dst, r_) do { dst[0] = bflo(r_.x); dst[1] = bfhi(r_.x); dst[2] = bflo(r_.y); dst[3] = bfhi(r_.y); dst[4] = bflo(r_.z); dst[5] = bfhi(r_.z); dst[6] = bflo(r_.w); dst[7] = bfhi(r_.w); } while (0)
        const int xhl = (cg8 >> 3) & 3;
#pragma unroll 1
        for (int hb = 0; hb < 2; ++hb) {
            u32x4 raw[11];
#pragma unroll
            for (int k = 0; k < 11; ++k) { const int tt = t0 + 8 * hb - 3 + k; raw[k] = (tt >= 0) ? *(const u32x4*)(src + (size_t)tt * NPROJ) : (u32x4){0u, 0u, 0u, 0u}; }
            CVTROW(u0, raw[0]); CVTROW(u1, raw[1]); CVTROW(u2, raw[2]);
#pragma unroll
            for (int li = 0; li < 8; ++li) {
                const int l = 16 * tg + 8 * hb + li; float u3[8], y[8];
                CVTROW(u3, raw[li + 3]);
#pragma unroll
                for (int e = 0; e < 8; ++e) { const float sv = bs[e] + w0[e] * u0[e] + w1[e] * u1[e] + w2[e] * u2[e] + w3[e] * u3[e]; y[e] = silu_f(sv); u0[e] = u1[e]; u1[e] = u2[e]; u2[e] = u3[e]; }
                u32x4 o; o.x = pk2(y[0], y[1]); o.y = pk2(y[2], y[3]); o.z = pk2(y[4], y[5]); o.w = pk2(y[6], y[7]);
                if (cg8 < 32) {
                    const float sc = dtl[xhl * 128 + l];
                    u32x4 sx; sx.x = pk2(y[0] * sc, y[1] * sc); sx.y = pk2(y[2] * sc, y[3] * sc); sx.z = pk2(y[4] * sc, y[5] * sc); sx.w = pk2(y[6] * sc, y[7] * sc);
                    const int p = (8 * cg8) & 63;
                    *(LAS u32x4*)(lds + xhl * 16384 + (p >> 5) * 8192 + l * 64 + (p & 31) * 2) = sx;
                } else if (cg8 < 48) {
                    *(LAS u32x4*)(bimg + l * 272 + 16 * (cg8 - 32)) = o;
                } else {
                    *(LAS u32x4*)(cimg + l * 272 + 16 * (cg8 - 48)) = o;
                    *(u32x4*)(F.CC + (row0 + l) * 256 + 128 * g + 8 * (cg8 - 48)) = o;
                }
            }
        }
#undef CVTROW
    }
    LDS_BARRIER();
    {
        const int hl = F.wave >> 1, ph = F.wave & 1, hh = lane >> 5;
        const int trow = 8 * hh + ((lane & 15) >> 2), tcol = 16 * ((lane >> 4) & 1) + 4 * (lane & 3);
        const LAS unsigned char* xa = lds + hl * 16384 + ph * 8192 + trow * 64 + tcol * 2; const LAS unsigned char* ba = bimg + trow * 272 + tcol * 2;
        f32x16 acc[4];
#pragma unroll
        for (int nb = 0; nb < 4; ++nb) acc[nb] = (f32x16){0.f};
#pragma unroll
        for (int ks = 0; ks < 8; ++ks) {
            const s16x4 xlo = trd(xa + ks * 1024), xhi = trd(xa + ks * 1024 + 256);
            const f32x4 dlo = *(const LAS f32x4*)(dec + hl * 128 + 16 * ks + 8 * hh), dhi = *(const LAS f32x4*)(dec + hl * 128 + 16 * ks + 8 * hh + 4);
            u32x4 aw;
            aw.x = pk2(__uint_as_float((unsigned)(unsigned short)xlo[0] << 16) * dlo[0], __uint_as_float((unsigned)(unsigned short)xlo[1] << 16) * dlo[1]);
            aw.y = pk2(__uint_as_float((unsigned)(unsigned short)xlo[2] << 16) * dlo[2], __uint_as_float((unsigned)(unsigned short)xlo[3] << 16) * dlo[3]);
            aw.z = pk2(__uint_as_float((unsigned)(unsigned short)xhi[0] << 16) * dhi[0], __uint_as_float((unsigned)(unsigned short)xhi[1] << 16) * dhi[1]);
            aw.w = pk2(__uint_as_float((unsigned)(unsigned short)xhi[2] << 16) * dhi[2], __uint_as_float((unsigned)(unsigned short)xhi[3] << 16) * dhi[3]);
            const bf16x8 af = __builtin_bit_cast(bf16x8, aw);
#pragma unroll
            for (int nb = 0; nb < 4; ++nb) { const LAS unsigned char* bp = ba + (16 * ks) * 272 + nb * 64; const bf16x8 bf = cat8(trd(bp), trd(bp + 4 * 272)); acc[nb] = mfma32(af, bf, acc[nb]); }
        }
        bf16_t* cs = F.CS + ((size_t)((b * 16 + c) * 8 + 4 * g + hl)) * 8192 + (lane & 31);
#pragma unroll
        for (int nb = 0; nb < 4; ++nb)
#pragma unroll
            for (int i = 0; i < 16; i += 2) { const int p = 32 * ph + (i & 3) + 8 * (i >> 2) + 4 * hh; const unsigned w2 = pk2(acc[nb][i], acc[nb][i + 1]);
                cs[(size_t)p * 128 + 32 * nb] = (bf16_t)(w2 & 0xffffu); cs[(size_t)(p + 1) * 128 + 32 * nb] = (bf16_t)(w2 >> 16); }
    }
    {
        const int hl = F.wave >> 1, head = 4 * g + hl, lq = lane & 31, hh = lane >> 5;
        const float dsk = F.d_skip[head];
        const int tra = (4 * hh + ((lane & 15) >> 2)) * 64 + (16 * ((lane >> 4) & 1) + 4 * (lane & 3)) * 2;
#pragma unroll 1
        for (int lbi = 0; lbi < 2; ++lbi) {
            const int lb = (F.wave & 1) ? (1 + lbi) : (3 * lbi);
            const int l = 32 * lb + lq; const float acl = acs[hl * 128 + l]; const float rdt = 1.0f / dtl[hl * 128 + l];
            bf16x8 cf[8];
#pragma unroll
            for (int ks = 0; ks < 8; ++ks) cf[ks] = *(const LAS bf16x8*)(cimg + l * 272 + (16 * ks + 8 * hh) * 2);
            f32x16 acc[2]; acc[0] = (f32x16){0.f}; acc[1] = (f32x16){0.f};
            for (int sb = 0; sb <= lb; ++sb) {
                f32x16 gt = (f32x16){0.f};
                { const LAS unsigned char* bp = bimg + (32 * sb + lq) * 272 + 16 * hh;
#pragma unroll
                  for (int ks = 0; ks < 8; ++ks) gt = mfma32(*(const LAS bf16x8*)(bp + 32 * ks), cf[ks], gt); }
                float pg[16];
#pragma unroll
                for (int i = 0; i < 16; ++i) { const int sl = (i & 3) + 8 * (i >> 2) + 4 * hh; const float e = __expf(acl - acs[hl * 128 + 32 * sb + sl]);
                    pg[i] = (sb < lb || sl <= lq) ? gt[i] * e : 0.f; }
                bf16x8 pf0, pf1;
                { u32x4 a4; a4.x = pk2(pg[0], pg[1]); a4.y = pk2(pg[2], pg[3]); a4.z = pk2(pg[4], pg[5]); a4.w = pk2(pg[6], pg[7]); pf0 = __builtin_bit_cast(bf16x8, a4);
                  u32x4 d4; d4.x = pk2(pg[8], pg[9]); d4.y = pk2(pg[10], pg[11]); d4.z = pk2(pg[12], pg[13]); d4.w = pk2(pg[14], pg[15]); pf1 = __builtin_bit_cast(bf16x8, d4); }
                const LAS unsigned char* xb = lds + hl * 16384 + (32 * sb) * 64 + tra;
#pragma unroll
                for (int ph = 0; ph < 2; ++ph) { const LAS unsigned char* xp = xb + ph * 8192;
                    acc[ph] = mfma32(cat8(trd(xp), trd(xp + 512)), pf0, acc[ph]); acc[ph] = mfma32(cat8(trd(xp + 1024), trd(xp + 1536)), pf1, acc[ph]); }
            }
            const LAS unsigned char* xp = lds + hl * 16384 + l * 64 + 8 * hh; bf16_t* op = F.MIX + (row0 + l) * 1024 + 512 + 256 * g + 64 * hl + 4 * hh;
#pragma unroll
            for (int ph = 0; ph < 2; ++ph)
#pragma unroll
                for (int k4 = 0; k4 < 4; ++k4) { const u32x2 xw = *(const LAS u32x2*)(xp + ph * 8192 + 16 * k4);
                    const float xs[4] = {bflo(xw.x), bfhi(xw.x), bflo(xw.y), bfhi(xw.y)};
                    u32x2 o; o.x = pk2(acc[ph][4 * k4] + dsk * (xs[0] * rdt), acc[ph][4 * k4 + 1] + dsk * (xs[1] * rdt)); o.y = pk2(acc[ph][4 * k4 + 2] + dsk * (xs[2] * rdt), acc[ph][4 * k4 + 3] + dsk * (xs[3] * rdt));
                    *(u32x2*)(op + 32 * ph + 8 * k4) = o; }
        }
    }
    LDS_BARRIER();
}

struct AU { int b, h, br, dsh, grp; };
__device__ __forceinline__ AU au_decode(int u) { AU a; a.grp = u & 7; int combo = u >> 3; a.br = combo % 3; combo /= 3; a.h = combo & 7; a.b = combo >> 3; a.dsh = 2 * a.br; return a; }
__device__ __forceinline__ int au_key_token(const AU& a, int j) {
    if (a.br == 2) return (j < 256) ? (2 * a.grp + (j >> 7)) + 16 * (j & 127) : -1;
    const int r = a.br == 0 ? 0 : (a.grp >> 1), base = a.br == 0 ? 256 * a.grp : 256 * (a.grp & 1), idx = base - 128 + j;
    return idx >= 0 ? r + (idx << a.dsh) : -1;
}
__device__ __forceinline__ void au_issue(const Ctx& F, int u, bf16x8 (&kr)[6], bf16x8 (&vr)[6], bf16x8 (&qn)[4]) {
    const AU a = au_decode(u); const int srow = F.tid >> 3, c8 = F.tid & 7, q = F.lane & 31, hh = F.lane >> 5, w = F.wave;
    const bf16_t* base = F.PROJ + (size_t)a.b * SEQ * NPROJ + a.h * 64;
#pragma unroll
    for (int i = 0; i < 6; ++i) { const int tok = au_key_token(a, 64 * i + srow);
        if (tok >= 0) { const bf16_t* p = base + (size_t)tok * NPROJ + 512 + 8 * c8; kr[i] = *(const bf16x8*)p; vr[i] = *(const bf16x8*)(p + 512); }
        else { kr[i] = (bf16x8){0, 0, 0, 0, 0, 0, 0, 0}; vr[i] = kr[i]; } }
    int qtok;
    if (a.br == 2) qtok = (2 * a.grp + (w >> 2)) + 16 * (32 * (w & 3) + q);
    else { const int r = a.br == 0 ? 0 : (a.grp >> 1), bq = a.br == 0 ? 256 * a.grp : 256 * (a.grp & 1); qtok = r + ((bq + 32 * w + q) << a.dsh); }
    const bf16_t* qp = base + (size_t)qtok * NPROJ + 8 * hh;
#pragma unroll
    for (int s = 0; s < 4; ++s) qn[s] = *(const bf16x8*)(qp + 16 * s);
}
__device__ __forceinline__ void attn_phase(const Ctx& F, float ref2) {
    constexpr int NU = 8 * 8 * 3 * 8;
    const int lane = F.lane, w = F.wave, q = lane & 31, hh = lane >> 5, srow = F.tid >> 3, c8 = F.tid & 7;
    LAS unsigned char* kimg = F.lds; LAS unsigned char* vimg = F.lds + 55296; LAS unsigned char* oimg = F.lds + 104448 + w * 4608;
    const int tra = (4 * hh + ((lane & 15) >> 2)) * 64 + (16 * ((lane >> 4) & 1) + 4 * (lane & 3)) * 2;
    bf16x8 kr[6], vr[6], qn[4];
    f32x16 negref;
#pragma unroll
    for (int i = 0; i < 16; ++i) negref[i] = -ref2;
    const bool xcdmap = (F.G % 8) == 0; const int ustep = xcdmap ? F.G / 8 : F.G, ubase = xcdmap ? (int)(blockIdx.x & 7) * (NU / 8) : 0, uend = xcdmap ? NU / 8 : NU;
    int ui = xcdmap ? (int)(blockIdx.x >> 3) : (int)blockIdx.x;
    if (ui < uend) au_issue(F, ubase + ui, kr, vr, qn);
    for (; ui < uend; ui += ustep) {
        const int u = ubase + ui;
        const AU a = au_decode(u);
        bf16x8 qf[4];
#pragma unroll
        for (int s = 0; s < 4; ++s) qf[s] = qn[s];
#pragma unroll
        for (int i = 0; i < 6; ++i) { const int j = 64 * i + srow;
            *(LAS bf16x8*)(kimg + j * 144 + c8 * 16) = kr[i];
            *(LAS bf16x8*)(vimg + (j >> 5) * 4096 + (c8 >> 2) * 2048 + (j & 31) * 64 + (c8 & 3) * 16) = vr[i]; }
        LDS_BARRIER();
        if (ui + ustep < uend) au_issue(F, u + ustep, kr, vr, qn);
        int kt0, st0, i0, qtok0;
        if (a.br == 2) { const int qt = w & 3; kt0 = 4 - qt; st0 = 4 * (w >> 2) + qt - 4; i0 = 32 * qt; qtok0 = 2 * a.grp + (w >> 2); }
        else { const int bq = a.br == 0 ? 256 * a.grp : 256 * (a.grp & 1); const int qtg = (bq >> 5) + w; kt0 = 4 - qtg; if (kt0 < 0) kt0 = 0; st0 = w; i0 = bq + 32 * w; qtok0 = a.br == 0 ? 0 : (a.grp >> 1); }
        f32x16 o0 = (f32x16){0.f}, o1 = (f32x16){0.f}; float lsum = 0.f;
        for (int kt = kt0; kt <= 4; ++kt) {
            const int st = st0 + kt;
            const LAS unsigned char* kp = kimg + (32 * st + q) * 144 + 16 * hh; const LAS unsigned char* vp = vimg + st * 4096 + tra;
            f32x16 sc = negref;
#pragma unroll
            for (int s = 0; s < 4; ++s) sc = mfma32(*(const LAS bf16x8*)(kp + 32 * s), qf[s], sc);
            float p[16];
#pragma unroll
            for (int i = 0; i < 16; ++i) p[i] = __builtin_amdgcn_exp2f(sc[i]);
            if (kt == 0) {
#pragma unroll
                for (int i = 0; i < 16; ++i) { const int kv = (i & 3) + 8 * (i >> 2) + 4 * hh; if (kv < q) p[i] = 0.f; } }
            if (kt == 4) {
#pragma unroll
                for (int i = 0; i < 16; ++i) { const int kv = (i & 3) + 8 * (i >> 2) + 4 * hh; if (kv > q) p[i] = 0.f; } }
#pragma unroll
            for (int i = 0; i < 16; ++i) lsum += p[i];
            bf16x8 pf0, pf1;
            { u32x4 x; x.x = pk2(p[0], p[1]); x.y = pk2(p[2], p[3]); x.z = pk2(p[4], p[5]); x.w = pk2(p[6], p[7]); pf0 = __builtin_bit_cast(bf16x8, x);
              u32x4 y; y.x = pk2(p[8], p[9]); y.y = pk2(p[10], p[11]); y.z = pk2(p[12], p[13]); y.w = pk2(p[14], p[15]); pf1 = __builtin_bit_cast(bf16x8, y); }
            { const bf16x8 a00 = cat8(trd(vp), trd(vp + 512)), a01 = cat8(trd(vp + 1024), trd(vp + 1536));
              const bf16x8 a10 = cat8(trd(vp + 2048), trd(vp + 2048 + 512)), a11 = cat8(trd(vp + 2048 + 1024), trd(vp + 2048 + 1536));
              o0 = mfma32(a00, pf0, o0); o0 = mfma32(a01, pf1, o0); o1 = mfma32(a10, pf0, o1); o1 = mfma32(a11, pf1, o1); }
        }
        lsum += __shfl_xor(lsum, 32);
#pragma unroll
        for (int g4 = 0; g4 < 4; ++g4) {
            u32x2 x; x.x = pk2(o0[4 * g4], o0[4 * g4 + 1]); x.y = pk2(o0[4 * g4 + 2], o0[4 * g4 + 3]); *(LAS u32x2*)(oimg + q * 144 + (8 * g4 + 4 * hh) * 2) = x;
            u32x2 y; y.x = pk2(o1[4 * g4], o1[4 * g4 + 1]); y.y = pk2(o1[4 * g4 + 2], o1[4 * g4 + 3]); *(LAS u32x2*)(oimg + q * 144 + (32 + 8 * g4 + 4 * hh) * 2) = y; }
        LDS_WAIT();
        { const int rowi = lane >> 3, cc = lane & 7;
          bf16_t* op = F.OP + ((size_t)a.br * M + (size_t)a.b * SEQ + qtok0) * 512 + a.h * 64 + 8 * cc;
#pragma unroll
          for (int i = 0; i < 4; ++i) __builtin_nontemporal_store(*(const LAS u32x4*)(oimg + (8 * i + rowi) * 144 + cc * 16), (u32x4*)(op + ((size_t)(i0 + 8 * i + rowi) << a.dsh) * 512)); }
        if (hh == 0) F.LP[((size_t)a.br * M + (size_t)a.b * SEQ + qtok0 + ((size_t)(i0 + q) << a.dsh)) * 8 + a.h] = lsum;
        LDS_BARRIER();
    }
}

__device__ __forceinline__ int xcd_affine(int s) { return (s & 7) * 32 + (s >> 3); }

__device__ __forceinline__ void p3_scan_merge(const Ctx& F) {
    const int gt = blockIdx.x * 512 + F.tid, NT = F.G * 512;
    for (int sl = blockIdx.x; sl < 256; sl += F.G) { const int idx = xcd_affine(sl) * 512 + F.tid;
        const int n4 = idx & 31, p = (idx >> 5) & 63, hd = (idx >> 11) & 7, b = idx >> 14;
        f32x4 st = (f32x4){0.f, 0.f, 0.f, 0.f};
        const size_t off0 = ((size_t)(b * 16 * 8 + hd)) * 8192 + p * 128 + 4 * n4;
        u32x2 cw[15]; float da[15];
#pragma unroll
        for (int c = 0; c < 15; ++c) { cw[c] = __builtin_nontemporal_load((const u32x2*)(F.CS + off0 + (size_t)c * 65536)); da[c] = F.ACS[((size_t)b * SEQ + c * 128 + 127) * 8 + hd]; }
        asm volatile("" ::: "memory");
#pragma unroll
        for (int c = 0; c < 16; ++c) {
            u32x2 o; o.x = pk2(st[0], st[1]); o.y = pk2(st[2], st[3]); *(u32x2*)(F.SIN + off0 + (size_t)c * 65536) = o;
            if (c < 15) st = st * __expf(da[c]) + (f32x4){bflo(cw[c].x), bfhi(cw[c].x), bflo(cw[c].y), bfhi(cw[c].y)};
        }
    }
    for (int sk = blockIdx.x; sk < 2048; sk += F.G) { const int sl = sk & 255, kk = sk >> 8; const int it = ((sl & 7) * 256 + (sl >> 3) * 8 + kk) * 512 + F.tid;
        const int dc = it & 7, h = (it >> 3) & 7; const size_t row = (size_t)(it >> 6);
        float l = 0.f; float o[8];
#pragma unroll
        for (int e = 0; e < 8; ++e) o[e] = 0.f;
#pragma unroll
        for (int br = 0; br < 3; ++br) {
            l += F.LP[((size_t)br * M + row) * 8 + h];
            const u32x4 w = __builtin_nontemporal_load((const u32x4*)(F.OP + ((size_t)br * M + row) * 512 + h * 64 + 8 * dc));
            o[0] += bflo(w.x); o[1] += bfhi(w.x); o[2] += bflo(w.y); o[3] += bfhi(w.y); o[4] += bflo(w.z); o[5] += bfhi(w.z); o[6] += bflo(w.w); o[7] += bfhi(w.w);
        }
        const float inv = 1.0f / l;
        u32x4 r; r.x = pk2(o[0] * inv, o[1] * inv); r.y = pk2(o[2] * inv, o[3] * inv); r.z = pk2(o[4] * inv, o[5] * inv); r.w = pk2(o[6] * inv, o[7] * inv);
        *(u32x4*)(F.MIX + row * 1024 + h * 64 + 8 * dc) = r;
    }
}

__device__ __forceinline__ void ssdb_issue(const Ctx& F, int u, u32x2 (&zr)[2][4], u32x2 (&yr)[2][4], u32x4 (&cr4)[4], float (&eal)[2]) {
    const int g = u & 1, c = (u >> 1) & 15, b = u >> 5; const size_t row0 = (size_t)b * SEQ + c * 128;
    const int hl = F.wave >> 1, head = 4 * g + hl, lq = F.lane & 31, hh = F.lane >> 5;
#pragma unroll
    for (int lbi = 0; lbi < 2; ++lbi) { const int lb = (F.wave & 1) ? (1 + lbi) : (3 * lbi); eal[lbi] = F.ACS[(row0 + 32 * lb + lq) * 8 + head]; }
    {   const int l = 32 * ((F.wave & 1) ? 1 : 0) + lq;
        const bf16_t* op = F.MIX + (row0 + l) * 1024 + 512 + 256 * g + 64 * hl + 4 * hh; const bf16_t* zp = F.PROJ + (row0 + l) * NPROJ + 1536 + 256 * g + 64 * hl + 4 * hh;
#pragma unroll
        for (int ph = 0; ph < 2; ++ph)
#pragma unroll
            for (int k4 = 0; k4 < 4; ++k4) { zr[ph][k4] = *(const u32x2*)(zp + 32 * ph + 8 * k4); yr[ph][k4] = *(const u32x2*)(op + 32 * ph + 8 * k4); }
    }
    const int brow = F.tid >> 4, bcol = 8 * (F.tid & 15);
    const bf16_t* bp = F.CC + (row0 + brow) * 256 + 128 * g + bcol;
#pragma unroll
    for (int i = 0; i < 4; ++i) cr4[i] = *(const u32x4*)(bp + (size_t)(32 * i) * 256);
}
__device__ __forceinline__ void ssdb_unit(const Ctx& F, int u, const u32x2 (&zr)[2][4], const u32x2 (&yr)[2][4], const u32x4 (&cr4)[4], const float (&ealv)[2]) {
    const int g = u & 1, c = (u >> 1) & 15, b = u >> 5; const size_t row0 = (size_t)b * SEQ + c * 128;
    LAS unsigned char* lds = F.lds; const int lane = F.lane;
    LAS unsigned char* cimg = lds; LAS float* ssq = (LAS float*)(lds + 34816);
    const int hl = F.wave >> 1, head = 4 * g + hl, lq = lane & 31, hh = lane >> 5;
    bf16x8 sin[2][8];
    { const bf16_t* sp = F.SIN + ((size_t)((b * 16 + c) * 8 + head)) * 8192 + (size_t)lq * 128 + 8 * hh;
#pragma unroll
      for (int ph = 0; ph < 2; ++ph)
#pragma unroll
          for (int ks = 0; ks < 8; ++ks) sin[ph][ks] = *(const bf16x8*)(sp + (size_t)ph * 32 * 128 + 16 * ks); }
    { const int brow = F.tid >> 4, bcol = 8 * (F.tid & 15);
#pragma unroll
      for (int i = 0; i < 4; ++i) *(LAS u32x4*)(cimg + (brow + 32 * i) * 272 + bcol * 2) = cr4[i]; }
    LDS_BARRIER();
    u32x2 z1[2][4], y1[2][4];
#pragma unroll
    for (int lbi = 0; lbi < 2; ++lbi) {
        const int lb = (F.wave & 1) ? (1 + lbi) : (3 * lbi);
        const int l = 32 * lb + lq;
        const float eal = __expf(ealv[lbi]);
        bf16_t* op = F.MIX + (row0 + l) * 1024 + 512 + 256 * g + 64 * hl + 4 * hh;
        if (lbi == 0) {
            const int l1 = 32 * ((F.wave & 1) ? 2 : 3) + lq;
            const bf16_t* op1 = F.MIX + (row0 + l1) * 1024 + 512 + 256 * g + 64 * hl + 4 * hh; const bf16_t* zp1 = F.PROJ + (row0 + l1) * NPROJ + 1536 + 256 * g + 64 * hl + 4 * hh;
#pragma unroll
            for (int ph = 0; ph < 2; ++ph)
#pragma unroll
                for (int k4 = 0; k4 < 4; ++k4) { z1[ph][k4] = *(const u32x2*)(zp1 + 32 * ph + 8 * k4); y1[ph][k4] = *(const u32x2*)(op1 + 32 * ph + 8 * k4); }
        }
        bf16x8 cf[8];
#pragma unroll
        for (int ks = 0; ks < 8; ++ks) cf[ks] = *(const LAS bf16x8*)(cimg + l * 272 + (16 * ks + 8 * hh) * 2);
        f32x16 acc[2];
#pragma unroll
        for (int ph = 0; ph < 2; ++ph) { f32x16 a = (f32x16){0.f};
#pragma unroll
            for (int ks = 0; ks < 8; ++ks) a = mfma32(sin[ph][ks], cf[ks], a);
            acc[ph] = a * eal; }
        float ss = 0.f;
#pragma unroll
        for (int ph = 0; ph < 2; ++ph)
#pragma unroll
            for (int k4 = 0; k4 < 4; ++k4) { const u32x2 yw = lbi == 0 ? yr[ph][k4] : y1[ph][k4], zw = lbi == 0 ? zr[ph][k4] : z1[ph][k4];
                const float ys[4] = {bflo(yw.x), bfhi(yw.x), bflo(yw.y), bfhi(yw.y)}, zs[4] = {bflo(zw.x), bfhi(zw.x), bflo(zw.y), bfhi(zw.y)};
#pragma unroll
                for (int e = 0; e < 4; ++e) { const float y = (acc[ph][4 * k4 + e] + ys[e]) * silu_f(zs[e]); acc[ph][4 * k4 + e] = y; ss += y * y; } }
        ss += __shfl_xor(ss, 32);
        if (hh == 0) ssq[lbi * 512 + hl * 128 + l] = ss;
        LDS_BARRIER();
        const LAS float* sq = ssq + lbi * 512 + l;
        const float rstd = rsqrtf(((sq[0] + sq[128]) + (sq[256] + sq[384])) * (1.0f / 256.0f) + 1e-6f);
        const float* wp = F.ssd_norm_w + 256 * g + 64 * hl + 4 * hh;
#pragma unroll
        for (int ph = 0; ph < 2; ++ph)
#pragma unroll
            for (int k4 = 0; k4 < 4; ++k4) { const f32x4 w = *(const f32x4*)(wp + 32 * ph + 8 * k4); const f32x16 y = acc[ph];
                u32x2 o; o.x = pk2(y[4 * k4] * rstd * w[0], y[4 * k4 + 1] * rstd * w[1]); o.y = pk2(y[4 * k4 + 2] * rstd * w[2], y[4 * k4 + 3] * rstd * w[3]);
                *(u32x2*)(op + 32 * ph + 8 * k4) = o; }
    }
    LDS_BARRIER();
}

struct Args { const float* in[15]; float* out; unsigned char* ws; int ph_lo, ph_hi; };
__global__ void __launch_bounds__(512) hybrid_fwd(Args args) {
    extern __shared__ __attribute__((aligned(16))) unsigned char lds_raw[];
    Ctx F;
    F.x = args.in[0]; F.attn_norm_w = args.in[1]; F.w_in = args.in[2]; F.q_norm_w = args.in[3]; F.k_norm_w = args.in[4]; F.conv_w = args.in[5]; F.conv_b = args.in[6];
    F.dt_bias = args.in[7]; F.a_log = args.in[8]; F.d_skip = args.in[9]; F.ssd_norm_w = args.in[10]; F.w_out = args.in[11]; F.mlp_norm_w = args.in[12]; F.w_up = args.in[13]; F.w_down = args.in[14];
    F.out = args.out; F.ws = args.ws; unsigned char* ws = args.ws;
    F.Win = (bf16_t*)(ws + WS_WIN); F.Wout = (bf16_t*)(ws + WS_WOUT); F.Wup = (bf16_t*)(ws + WS_WUP); F.Wdown = (bf16_t*)(ws + WS_WDOWN);
    F.H = (bf16_t*)(ws + WS_H); F.XBCC = (bf16_t*)(ws + WS_XBCC); F.PROJ = (bf16_t*)(ws + WS_PROJ); F.ACT = (bf16_t*)(ws + WS_ACT); F.MIX = (bf16_t*)(ws + WS_MIX);
    F.X1B = (bf16_t*)(ws + WS_X1B); F.SIN = (bf16_t*)(ws + WS_SIN); F.OP = (bf16_t*)args.out;
    F.ROPEC = (float*)(ws + WS_ROPE); F.ROPES = F.ROPEC + SEQ * 32; F.DT = (float*)(ws + WS_DT); F.ACS = (float*)(ws + WS_ACS); F.PART = (float*)(ws + WS_PART); F.LP = (float*)(ws + WS_LP); F.CS = (bf16_t*)(ws + WS_CS); F.CC = (bf16_t*)(ws + WS_CC); F.RS = (float*)(ws + WS_RS);
    F.lds = (LAS unsigned char*)lds_raw; F.tid = threadIdx.x; F.lane = F.tid & 63; F.wave = __builtin_amdgcn_readfirstlane(F.tid >> 6); F.G = gridDim.x;
    const int lo = args.ph_lo, hi = args.ph_hi;
#define IN(k) (lo <= (k) && (k) < hi)
#define SEAM(k) do { if (IN(k) && IN((k) + 1)) { xcd_barrier(bar); if ((MK_REPEAT >> 12) & 1) xcd_barrier(bar); } } while (0)
#define SEAM_SHADOW(k, seam, nodrain) do { if (IN(k) && IN((k) + 1)) { asm volatile("s_waitcnt vmcnt(0)" ::: "memory"); __syncthreads(); shadow_weights(F, seam); \
        if (threadIdx.x == 0) xcd_barrier_leader(bar); if (nodrain) LDS_BARRIER(); else __syncthreads(); } else if (IN(k)) { __syncthreads(); shadow_weights(F, seam); } } while (0)
    if (lo > 1000) cg::this_grid().sync();
    volatile LAS unsigned* bst = (volatile LAS unsigned*)(F.lds + LDS_BYTES - 16);
    if (F.tid < 2) bst[F.tid] = 0u;
    __syncthreads();
    XcdBarrier bar = xcd_barrier_post((unsigned*)(ws + WS_BAR), bst);

    if (IN(0)) REP(0) p0_prologue(F);
    SEAM(0);
    if (IN(1)) REP(1) { pg8::Gemm gm{F.H, F.Win, M, NPROJ, D}; pg8::StaticOrder S; S.init(M, NPROJ, F.G, (int)blockIdx.x);
        pg8::EpiInProj E{F.PROJ, F.q_norm_w, F.k_norm_w, F.ROPEC, F.ROPES};
        pg8::f32x4 lacc[2][2][4][2]; pg8::gemm_phase<pg8::EpiInProj, pg8::StaticOrder, true, true>(F.lds, gm, S, E, lacc); }
    SEAM_SHADOW(1, 0, true);
    if (IN(2)) REP(2) {
        for (int sl = blockIdx.x; sl < 256; sl += F.G) ssda_unit(F, xcd_affine(sl));
        float mq = fabsf(F.q_norm_w[F.lane]), mk = fabsf(F.k_norm_w[F.lane]);
#pragma unroll
        for (int o = 1; o < 64; o <<= 1) { mq = fmaxf(mq, __shfl_xor(mq, o)); mk = fmaxf(mk, __shfl_xor(mk, o)); }
        const float ref2 = pg8::QSCALE * 64.0f * mq * mk;
        REP(11) attn_phase(F, ref2);
    }
    SEAM_SHADOW(2, 1, true);
    if (IN(3)) REP(3) p3_scan_merge(F);
    {
        u32x2 pzr[2][4], pyr[2][4]; u32x4 pcr[4]; float peal[2];
        const bool p4first = IN(4) && (int)blockIdx.x < 256;
        if (IN(3) && IN(4)) {
            asm volatile("s_waitcnt vmcnt(0)" ::: "memory"); __syncthreads();
            if (p4first && F.wave != 0) ssdb_issue(F, xcd_affine(blockIdx.x), pzr, pyr, pcr, peal);
            if (threadIdx.x == 0) xcd_barrier_leader(bar);
            LDS_BARRIER();
            if (p4first && F.wave == 0) ssdb_issue(F, xcd_affine(blockIdx.x), pzr, pyr, pcr, peal);
        } else if (p4first) ssdb_issue(F, xcd_affine(blockIdx.x), pzr, pyr, pcr, peal);
        if (p4first) ssdb_unit(F, xcd_affine(blockIdx.x), pzr, pyr, pcr, peal);
        if (IN(4)) {
#pragma unroll 1
            for (int sl = blockIdx.x + F.G; sl < 256; sl += F.G) { const int u = xcd_affine(sl); ssdb_issue(F, u, pzr, pyr, pcr, peal); ssdb_unit(F, u, pzr, pyr, pcr, peal); } }
    }
    const int pwr = F.wave >> 2, pwc = F.wave & 3, pfr = F.lane & 15, pfq = F.lane >> 4;
    {   pg8::f32x4 gacc[2][2][4][2]; pg8::StaticOrder S; S.init(M, D, F.G, (int)blockIdx.x); pg8::Unit u0; const bool has = IN(5) && S.next(0, u0);
        if (IN(4) && IN(5)) {
            asm volatile("s_waitcnt vmcnt(0)" ::: "memory"); __syncthreads();
            if (has && F.wave != 0) pg8::preload_h_tile(gacc, F.H, F.RS, F.attn_norm_w, u0, pwr, pwc, pfr, pfq);
            if (threadIdx.x == 0) xcd_barrier_leader(bar);
            LDS_BARRIER();
            if (has && F.wave == 0) pg8::preload_h_tile(gacc, F.H, F.RS, F.attn_norm_w, u0, pwr, pwc, pfr, pfq);
        } else if (has) pg8::preload_h_tile(gacc, F.H, F.RS, F.attn_norm_w, u0, pwr, pwc, pfr, pfq);
        if (IN(5)) { pg8::Gemm gm{F.MIX, F.Wout, M, D, D};
            pg8::EpiOutProjPre E{F.X1B, F.PART};
            pg8::gemm_phase<pg8::EpiOutProjPre, pg8::StaticOrder, true, true, true>(F.lds, gm, S, E, gacc); }
    }
    SEAM_SHADOW(5, 2, false);
    if (IN(6)) { pg8::Gemm gm{F.X1B, F.Wup, M, FF, D}; pg8::StaticOrder S; S.init(M, FF, F.G, (int)blockIdx.x);
        LAS float* rt = (LAS float*)(F.lds + 131072 + 2048); int pmc = -1;
        { pg8::Unit u0; if (S.next(0, u0)) { pmc = u0.pm; const float* pp = F.PART + ((size_t)u0.pm * 256 + (F.tid >> 1)) * 16 + 8 * (F.tid & 1);
            const f32x4 a = *(const f32x4*)pp, b = *(const f32x4*)(pp + 4); float sq = ((a[0] + a[1]) + (a[2] + a[3])) + ((b[0] + b[1]) + (b[2] + b[3])); sq += __shfl_xor(sq, 1);
            if (!(F.tid & 1)) rt[F.tid >> 1] = rsqrtf(sq * (1.0f / 1024.0f) + 1e-6f); } }
        __syncthreads();
        pg8::EpiUpT E{F.ACT, F.PART, rt, pmc};
        pg8::f32x4 lacc[2][2][4][2]; pg8::gemm_phase<pg8::EpiUpT, pg8::StaticOrder, true, true>(F.lds, gm, S, E, lacc); }
    {   pg8::f32x4 gacc[2][2][4][2]; pg8::StaticOrder S; S.init(M, D, F.G, (int)blockIdx.x); pg8::Unit u0; const bool has = IN(7) && S.next(0, u0);
        if (IN(6) && IN(7)) {
            asm volatile("s_waitcnt vmcnt(0)" ::: "memory"); __syncthreads();
            if (has && F.wave != 0) pg8::preload_bf16_tile(gacc, F.X1B, u0, pwr, pwc, pfr, pfq);
            if (threadIdx.x == 0) xcd_barrier_leader(bar);
            LDS_BARRIER();
            if (has && F.wave == 0) pg8::preload_bf16_tile(gacc, F.X1B, u0, pwr, pwc, pfr, pfq);
        } else if (has) pg8::preload_bf16_tile(gacc, F.X1B, u0, pwr, pwc, pfr, pfq);
        if (IN(7)) { pg8::Gemm gm{F.ACT, F.Wdown, M, D, FF};
            pg8::EpiDownPre E{F.out};
            pg8::gemm_phase<pg8::EpiDownPre, pg8::StaticOrder, true, true, true>(F.lds, gm, S, E, gacc); }
    }
#undef IN
#undef SEAM
}

extern "C" void kernel_launch(void* const* d_in, const int* in_sizes, int n_in, void* d_out, int out_size, void* d_ws, size_t ws_size, hipStream_t stream) {
    static int grid = 0;
    if (grid == 0) {
        if (n_in != 15 || out_size != M * D || ws_size < WS_END) { fprintf(stderr, "kernel_launch: unexpected shapes (n_in %d, out %d, ws %zu)\n", n_in, out_size, ws_size); grid = -1; return; }
        int dev = 0, cus = 0, per_cu = 0;
        if (hipGetDevice(&dev) != hipSuccess || hipDeviceGetAttribute(&cus, hipDeviceAttributeMultiprocessorCount, dev) != hipSuccess) { grid = -1; return; }
        if (hipFuncSetAttribute((const void*)hybrid_fwd, hipFuncAttributeMaxDynamicSharedMemorySize, LDS_BYTES) != hipSuccess) { fprintf(stderr, "kernel_launch: hipFuncSetAttribute failed\n"); grid = -1; return; }
        if (hipOccupancyMaxActiveBlocksPerMultiprocessor(&per_cu, (const void*)hybrid_fwd, 512, LDS_BYTES) != hipSuccess || per_cu < 1) { fprintf(stderr, "kernel_launch: occupancy query says %d blocks per CU\n", per_cu); (void)hipGetLastError(); per_cu = 1; }
        grid = cus * per_cu;
    }
    if (grid < 0) return;
    if (hipMemsetAsync((char*)d_ws + WS_BAR, 0, XCD_BAR_WORDS * 4, stream) != hipSuccess) { fprintf(stderr, "kernel_launch: memset of the barrier words failed\n"); return; }
    Args a{};
    for (int i = 0; i < 15; ++i) a.in[i] = (const float*)d_in[i];
    a.out = (float*)d_out; a.ws = (unsigned char*)d_ws;
#if MK_SPLIT
    for (int ph = 0; ph < NPHASE; ++ph) { a.ph_lo = ph; a.ph_hi = ph + 1; hipLaunchKernelGGL(hybrid_fwd, dim3(grid), dim3(512), LDS_BYTES, stream, a); }
#else
    a.ph_lo = 0; a.ph_hi = NPHASE;
    void* kargs[] = {&a};
    const hipError_t e = hipLaunchCooperativeKernel((const void*)hybrid_fwd, dim3(grid), dim3(512), kargs, LDS_BYTES, stream);
    if (e != hipSuccess) fprintf(stderr, "kernel_launch: cooperative launch failed: %s (grid %d)\n", hipGetErrorString(e), grid);
#endif
}
```

```cpp
#include <hip/hip_runtime.h>
#include <hip/hip_cooperative_groups.h>
#include <cstdio>
#include <cstdint>
namespace cg = cooperative_groups;
#ifndef MK_REPEAT
#define MK_REPEAT 0
#endif
namespace pg8 {
#define PG8_LAS __attribute__((address_space(3)))
typedef unsigned short bf16_t;
typedef short bf16x8 __attribute__((ext_vector_type(8)));
typedef float f32x4 __attribute__((ext_vector_type(4)));
typedef unsigned u32x4 __attribute__((ext_vector_type(4)));
constexpr int BM = 256, BK = 64, HALF = 128, HTB = HALF * BK * 2  , STAGE_BYTES = 8 * HTB, NXCD = 8, WGM = 8;

__host__ __device__ __forceinline__ int lds_byte(int r, int c) { const int st = (r >> 4) * 2 + (c >> 5), rr = r & 15, cc = c & 31, ob = rr * 64 + cc * 2; return st * 1024 + (ob ^ (((ob >> 9) & 1) << 5)); }
__host__ __device__ __forceinline__ void stage_rc(int b, int& R, int& C) { const int st = b / 1024, sb = b % 1024, swz = sb ^ (((sb >> 9) & 1) << 5); R = (st >> 1) * 16 + swz / 64; C = (st & 1) * 32 + (swz % 64) / 2; }
__host__ __device__ __forceinline__ int perm32(int rho) { const int n = rho >> 4, i = rho & 15; return 8 * (i >> 2) + 4 * n + (i & 3); }

struct Unit { int pm, pn; };
struct Gemm { const bf16_t* A; const bf16_t* Bt; int M, N, K; };

struct StaticOrder {
    int nM, nN, nwg, G, c;
    __host__ __device__ void init(int M, int N, int G_, int c_) { nM = M / BM; nN = N / BM; nwg = nM * nN; G = G_; c = c_; }
    __host__ __device__ bool next(int i, Unit& u) const {
        const long L = (long)i * G + c; if (L >= nwg) return false;
        int wgid = (int)L; { const int q = nwg / NXCD, r = nwg % NXCD, xcd = wgid % NXCD, off = wgid / NXCD; wgid = (xcd < r ? xcd * (q + 1) : r * (q + 1) + (xcd - r) * q) + off; }
        const int nig = WGM * nN, gid = wgid / nig, fm = gid * WGM, gsz = (nM - fm) < WGM ? (nM - fm) : WGM;
        u.pm = fm + ((wgid % nig) % gsz); u.pn = (wgid % nig) / gsz; return true;
    }
    __device__ __forceinline__ void a_ready(const Unit&) const {}
    __device__ __forceinline__ void done(const Unit&) const {}
};


typedef float f32x2_t __attribute__((ext_vector_type(2))); typedef __bf16 bf16x2_t __attribute__((ext_vector_type(2)));
__device__ __forceinline__ unsigned pk2(float lo, float hi) { f32x2_t v = {lo, hi}; bf16x2_t b = __builtin_convertvector(v, bf16x2_t); return __builtin_bit_cast(unsigned, b); }
__device__ __forceinline__ u32x4 pk8(const f32x4 a, const f32x4 b) { u32x4 w; w.x = pk2(a[0], a[1]); w.y = pk2(a[2], a[3]); w.z = pk2(b[0], b[1]); w.w = pk2(b[2], b[3]); return w; }

constexpr float QSCALE = 0.18033688011112042f;
constexpr float NORM_EPS = 1e-6f;
constexpr int PROJ_LD = 3072;

#define EPI_FENCE() asm volatile("" ::: "memory")

struct EpiInProj {
    static constexpr bool PERM = true, AFTER_DRAIN = false;
    bf16_t* P; const float* qw; const float* kw; const float* rc; const float* rs;
    __device__ __forceinline__ void operator()(const f32x4 (&acc)[2][2][4][2], const Unit& u, int wr, int wc, int fr, int fq) const {
        const int row0 = u.pm * BM + wr * 64 + fr, cbase = u.pn * BM + 64 * wc + 8 * fq;
        if (u.pn < 4) {
            const bool isq = u.pn < 2; const float* w = isq ? qw : kw; const float osc = isq ? QSCALE : 1.0f;
            f32x4 wv[2][2];
#pragma unroll
            for (int bj = 0; bj < 2; ++bj)
#pragma unroll
                for (int n = 0; n < 2; ++n) wv[bj][n] = *(const f32x4*)(w + 32 * bj + 8 * fq + 4 * n);
            f32x4 tc[2][2], ts[2][2];
#pragma unroll
            for (int g = 0; g < 2; ++g) { const int t = (row0 + g * 16) & 2047;
#pragma unroll
                for (int n = 0; n < 2; ++n) { tc[g][n] = *(const f32x4*)(rc + t * 32 + 8 * fq + 4 * n); ts[g][n] = *(const f32x4*)(rs + t * 32 + 8 * fq + 4 * n); } }
            EPI_FENCE();
#pragma unroll
            for (int g = 0; g < 8; ++g) {
                const int ai = g >> 2, m = g & 3, row = row0 + ai * HALF + m * 16;
                float ss = 0.f;
#pragma unroll
                for (int bj = 0; bj < 2; ++bj)
#pragma unroll
                    for (int n = 0; n < 2; ++n) { const f32x4 v = acc[ai][bj][m][n]; ss += (v[0] * v[0] + v[1] * v[1]) + (v[2] * v[2] + v[3] * v[3]); }
                ss += __shfl_xor(ss, 16); ss += __shfl_xor(ss, 32);
                const float rstd = rsqrtf(ss * (1.0f / 64.0f) + NORM_EPS);
                f32x4 o1[2], o2[2];
#pragma unroll
                for (int n = 0; n < 2; ++n) {
                    const f32x4 cs = tc[g & 1][n], sn = ts[g & 1][n];
                    const f32x4 x1 = acc[ai][0][m][n] * rstd * wv[0][n], x2 = acc[ai][1][m][n] * rstd * wv[1][n];
                    o1[n] = (x1 * cs - x2 * sn) * osc; o2[n] = (x2 * cs + x1 * sn) * osc;
                }
                bf16_t* rp = P + (size_t)row * PROJ_LD + cbase;
                *(u32x4*)(rp) = pk8(o1[0], o1[1]); *(u32x4*)(rp + 32) = pk8(o2[0], o2[1]);
                if (g + 2 < 8) { const int g2 = g + 2; const int t = (row0 + (g2 >> 2) * HALF + (g2 & 3) * 16) & 2047;
#pragma unroll
                    for (int n = 0; n < 2; ++n) { tc[g & 1][n] = *(const f32x4*)(rc + t * 32 + 8 * fq + 4 * n); ts[g & 1][n] = *(const f32x4*)(rs + t * 32 + 8 * fq + 4 * n); } }
                EPI_FENCE();
            }
        } else {
#pragma unroll
            for (int ai = 0; ai < 2; ++ai)
#pragma unroll
                for (int m = 0; m < 4; ++m) { bf16_t* rp = P + (size_t)(row0 + ai * HALF + m * 16) * PROJ_LD + cbase;
#pragma unroll
                    for (int bj = 0; bj < 2; ++bj) *(u32x4*)(rp + 32 * bj) = pk8(acc[ai][bj][m][0], acc[ai][bj][m][1]); }
        }
    }
};

struct EpiOutProj {
    static constexpr bool PERM = true, AFTER_DRAIN = false;
    const float* x; bf16_t* x1b; float* part;
    __device__ __forceinline__ void operator()(const f32x4 (&acc)[2][2][4][2], const Unit& u, int wr, int wc, int fr, int fq) const {
        const int row0 = u.pm * BM + wr * 64 + fr, c0 = u.pn * BM + wc * 32 + 8 * fq;
        f32x4 pre[4][2][2];
#pragma unroll
        for (int g = 0; g < 4; ++g) { const float* xp = x + (size_t)(row0 + g * 16) * 1024 + c0;
#pragma unroll
            for (int bj = 0; bj < 2; ++bj) { pre[g][bj][0] = *(const f32x4*)(xp + bj * HALF); pre[g][bj][1] = *(const f32x4*)(xp + bj * HALF + 4); } }
        EPI_FENCE();
#pragma unroll
        for (int g = 0; g < 8; ++g) {
            const int ai = g >> 2, m = g & 3, row = row0 + ai * HALF + m * 16; const size_t off = (size_t)row * 1024 + c0; float ss = 0.f;
#pragma unroll
            for (int bj = 0; bj < 2; ++bj) {
                const f32x4 a = acc[ai][bj][m][0] + pre[m][bj][0], b = acc[ai][bj][m][1] + pre[m][bj][1];
                *(u32x4*)(x1b + off + bj * HALF) = pk8(a, b);
                ss += (a[0] * a[0] + a[1] * a[1]) + (a[2] * a[2] + a[3] * a[3]) + (b[0] * b[0] + b[1] * b[1]) + (b[2] * b[2] + b[3] * b[3]);
            }
            if (g + 4 < 8) { const float* xp = x + (size_t)(row0 + HALF + m * 16) * 1024 + c0;
#pragma unroll
                for (int bj = 0; bj < 2; ++bj) { pre[m][bj][0] = *(const f32x4*)(xp + bj * HALF); pre[m][bj][1] = *(const f32x4*)(xp + bj * HALF + 4); } }
            ss += __shfl_xor(ss, 16); ss += __shfl_xor(ss, 32);
            if (fq == 0) part[(size_t)row * 16 + u.pn * 4 + wc] = ss;
            EPI_FENCE();
        }
    }
};

struct EpiUp {
    static constexpr bool PERM = true, AFTER_DRAIN = false;
    bf16_t* act; const float* part;
    __device__ __forceinline__ void operator()(const f32x4 (&acc)[2][2][4][2], const Unit& u, int wr, int wc, int fr, int fq) const {
        const int row0 = u.pm * BM + wr * 64 + fr, c0 = u.pn * BM + wc * 32 + 8 * fq;
        f32x4 pp[8];
#pragma unroll
        for (int g = 0; g < 8; ++g) pp[g] = *(const f32x4*)(part + (size_t)(row0 + (g >> 2) * HALF + (g & 3) * 16) * 16 + 4 * fq);
        EPI_FENCE();
        float rstd[8];
#pragma unroll
        for (int g = 0; g < 8; ++g) { float s = (pp[g][0] + pp[g][1]) + (pp[g][2] + pp[g][3]); s += __shfl_xor(s, 16); s += __shfl_xor(s, 32); rstd[g] = rsqrtf(s * (1.0f / 1024.0f) + NORM_EPS); }
#pragma unroll
        for (int g = 0; g < 8; ++g) {
            const int ai = g >> 2, m = g & 3; bf16_t* rp = act + (size_t)(row0 + ai * HALF + m * 16) * 4096 + c0;
#pragma unroll
            for (int bj = 0; bj < 2; ++bj) {
                f32x4 a = acc[ai][bj][m][0] * rstd[g], b = acc[ai][bj][m][1] * rstd[g];
#pragma unroll
                for (int e = 0; e < 4; ++e) { a[e] = a[e] > 0.f ? a[e] * a[e] : 0.f; b[e] = b[e] > 0.f ? b[e] * b[e] : 0.f; }
                *(u32x4*)(rp + bj * HALF) = pk8(a, b);
            }
        }
    }
};

struct EpiDown {
    static constexpr bool PERM = true, AFTER_DRAIN = false;
    float* out; const bf16_t* x1b;
    __device__ __forceinline__ void operator()(const f32x4 (&acc)[2][2][4][2], const Unit& u, int wr, int wc, int fr, int fq) const {
        const int row0 = u.pm * BM + wr * 64 + fr, c0 = u.pn * BM + wc * 32 + 8 * fq;
        u32x4 pre[8][2];
#pragma unroll
        for (int g = 0; g < 8; ++g) { const bf16_t* xp = x1b + (size_t)(row0 + (g >> 2) * HALF + (g & 3) * 16) * 1024 + c0; pre[g][0] = *(const u32x4*)xp; pre[g][1] = *(const u32x4*)(xp + HALF); }
        EPI_FENCE();
#pragma unroll
        for (int g = 0; g < 8; ++g) {
            const int ai = g >> 2, m = g & 3; const size_t off = (size_t)(row0 + ai * HALF + m * 16) * 1024 + c0;
#pragma unroll
            for (int bj = 0; bj < 2; ++bj) { const u32x4 r = pre[g][bj];
                f32x4 a, b; a[0] = __uint_as_float(r.x << 16); a[1] = __uint_as_float(r.x & 0xffff0000u); a[2] = __uint_as_float(r.y << 16); a[3] = __uint_as_float(r.y & 0xffff0000u);
                b[0] = __uint_as_float(r.z << 16); b[1] = __uint_as_float(r.z & 0xffff0000u); b[2] = __uint_as_float(r.w << 16); b[3] = __uint_as_float(r.w & 0xffff0000u);
                *(f32x4*)(out + off + bj * HALF) = a + acc[ai][bj][m][0]; *(f32x4*)(out + off + bj * HALF + 4) = b + acc[ai][bj][m][1]; }
        }
    }
};


struct EpiUpT {
    static constexpr bool PERM = true, AFTER_DRAIN = false;
    bf16_t* act; const float* part; const PG8_LAS float* rt; int pmc;
    __device__ __forceinline__ void operator()(const f32x4 (&acc)[2][2][4][2], const Unit& u, int wr, int wc, int fr, int fq) const {
        const int row0 = u.pm * BM + wr * 64 + fr, c0 = u.pn * BM + wc * 32 + 8 * fq;
        float rstd[8];
        if (u.pm == pmc) {
#pragma unroll
            for (int g = 0; g < 8; ++g) rstd[g] = rt[(g >> 2) * HALF + wr * 64 + (g & 3) * 16 + fr];
        } else {
            f32x4 pp[8];
#pragma unroll
            for (int g = 0; g < 8; ++g) pp[g] = *(const f32x4*)(part + (size_t)(row0 + (g >> 2) * HALF + (g & 3) * 16) * 16 + 4 * fq);
            EPI_FENCE();
#pragma unroll
            for (int g = 0; g < 8; ++g) { float s = (pp[g][0] + pp[g][1]) + (pp[g][2] + pp[g][3]); s += __shfl_xor(s, 16); s += __shfl_xor(s, 32); rstd[g] = rsqrtf(s * (1.0f / 1024.0f) + NORM_EPS); }
        }
#pragma unroll
        for (int g = 0; g < 8; ++g) {
            const int ai = g >> 2, m = g & 3; bf16_t* rp = act + (size_t)(row0 + ai * HALF + m * 16) * 4096 + c0;
#pragma unroll
            for (int bj = 0; bj < 2; ++bj) {
                f32x4 a = acc[ai][bj][m][0] * rstd[g], b = acc[ai][bj][m][1] * rstd[g];
#pragma unroll
                for (int e = 0; e < 4; ++e) { a[e] = a[e] > 0.f ? a[e] * a[e] : 0.f; b[e] = b[e] > 0.f ? b[e] * b[e] : 0.f; }
                *(u32x4*)(rp + bj * HALF) = pk8(a, b);
            }
        }
    }
};

__device__ __forceinline__ void preload_f32_tile(f32x4 (&acc)[2][2][4][2], const float* x, const Unit& u, int wr, int wc, int fr, int fq) {
    const int row0 = u.pm * BM + wr * 64 + fr, c0 = u.pn * BM + wc * 32 + 8 * fq;
#pragma unroll
    for (int ai = 0; ai < 2; ++ai)
#pragma unroll
        for (int m = 0; m < 4; ++m) { const float* xp = x + (size_t)(row0 + ai * HALF + m * 16) * 1024 + c0;
#pragma unroll
            for (int bj = 0; bj < 2; ++bj) { acc[ai][bj][m][0] = *(const f32x4*)(xp + bj * HALF); acc[ai][bj][m][1] = *(const f32x4*)(xp + bj * HALF + 4); } }
}
__device__ __forceinline__ void preload_bf16_tile(f32x4 (&acc)[2][2][4][2], const bf16_t* xb, const Unit& u, int wr, int wc, int fr, int fq) {
    const int row0 = u.pm * BM + wr * 64 + fr, c0 = u.pn * BM + wc * 32 + 8 * fq;
#pragma unroll
    for (int ai = 0; ai < 2; ++ai)
#pragma unroll
        for (int m = 0; m < 4; ++m) { const bf16_t* xp = xb + (size_t)(row0 + ai * HALF + m * 16) * 1024 + c0;
#pragma unroll
            for (int bj = 0; bj < 2; ++bj) { const u32x4 r = *(const u32x4*)(xp + bj * HALF);
                acc[ai][bj][m][0] = (f32x4){__uint_as_float(r.x << 16), __uint_as_float(r.x & 0xffff0000u), __uint_as_float(r.y << 16), __uint_as_float(r.y & 0xffff0000u)};
                acc[ai][bj][m][1] = (f32x4){__uint_as_float(r.z << 16), __uint_as_float(r.z & 0xffff0000u), __uint_as_float(r.w << 16), __uint_as_float(r.w & 0xffff0000u)}; } }
}

__device__ __forceinline__ void preload_h_tile(f32x4 (&acc)[2][2][4][2], const bf16_t* H, const float* RS, const float* w, const Unit& u, int wr, int wc, int fr, int fq) {
    const int row0 = u.pm * BM + wr * 64 + fr, c0 = u.pn * BM + wc * 32 + 8 * fq;
    u32x4 raw[8][2]; float rs[8];
#pragma unroll
    for (int g = 0; g < 8; ++g) { const int row = row0 + (g >> 2) * HALF + (g & 3) * 16; const bf16_t* hp = H + (size_t)row * 1024 + c0;
        raw[g][0] = *(const u32x4*)hp; raw[g][1] = *(const u32x4*)(hp + HALF); rs[g] = RS[row]; }
    f32x4 iw[2][2];
#pragma unroll
    for (int bj = 0; bj < 2; ++bj)
#pragma unroll
        for (int n = 0; n < 2; ++n) { const f32x4 wv = *(const f32x4*)(w + c0 + bj * HALF + 4 * n); iw[bj][n] = (f32x4){1.0f / wv[0], 1.0f / wv[1], 1.0f / wv[2], 1.0f / wv[3]}; }
#pragma unroll
    for (int g = 0; g < 8; ++g) { const int ai = g >> 2, m = g & 3; const float ir = 1.0f / rs[g];
#pragma unroll
        for (int bj = 0; bj < 2; ++bj) { const u32x4 r = raw[g][bj];
            acc[ai][bj][m][0] = (f32x4){__uint_as_float(r.x << 16), __uint_as_float(r.x & 0xffff0000u), __uint_as_float(r.y << 16), __uint_as_float(r.y & 0xffff0000u)} * ir * iw[bj][0];
            acc[ai][bj][m][1] = (f32x4){__uint_as_float(r.z << 16), __uint_as_float(r.z & 0xffff0000u), __uint_as_float(r.w << 16), __uint_as_float(r.w & 0xffff0000u)} * ir * iw[bj][1]; } }
}
struct EpiOutProjPre {
    static constexpr bool PERM = true, AFTER_DRAIN = false;
    bf16_t* x1b; float* part;
    __device__ __forceinline__ void operator()(const f32x4 (&acc)[2][2][4][2], const Unit& u, int wr, int wc, int fr, int fq) const {
        const int row0 = u.pm * BM + wr * 64 + fr, c0 = u.pn * BM + wc * 32 + 8 * fq;
#pragma unroll
        for (int g = 0; g < 8; ++g) {
            const int ai = g >> 2, m = g & 3, row = row0 + ai * HALF + m * 16; const size_t off = (size_t)row * 1024 + c0; float ss = 0.f;
#pragma unroll
            for (int bj = 0; bj < 2; ++bj) { const f32x4 a = acc[ai][bj][m][0], b = acc[ai][bj][m][1];
                *(u32x4*)(x1b + off + bj * HALF) = pk8(a, b);
                ss += (a[0] * a[0] + a[1] * a[1]) + (a[2] * a[2] + a[3] * a[3]) + (b[0] * b[0] + b[1] * b[1]) + (b[2] * b[2] + b[3] * b[3]); }
            ss += __shfl_xor(ss, 16); ss += __shfl_xor(ss, 32);
            if (fq == 0) part[(size_t)row * 16 + u.pn * 4 + wc] = ss;
        }
    }
};
struct EpiDownPre {
    static constexpr bool PERM = true, AFTER_DRAIN = false;
    float* out;
    __device__ __forceinline__ void operator()(const f32x4 (&acc)[2][2][4][2], const Unit& u, int wr, int wc, int fr, int fq) const {
        const int row0 = u.pm * BM + wr * 64 + fr, c0 = u.pn * BM + wc * 32 + 8 * fq;
#pragma unroll
        for (int ai = 0; ai < 2; ++ai)
#pragma unroll
            for (int m = 0; m < 4; ++m) { float* rp = out + (size_t)(row0 + ai * HALF + m * 16) * 1024 + c0;
#pragma unroll
                for (int bj = 0; bj < 2; ++bj) { *(f32x4*)(rp + bj * HALF) = acc[ai][bj][m][0]; *(f32x4*)(rp + bj * HALF + 4) = acc[ai][bj][m][1]; } }
    }
};

template <class Epi, class Sched, bool ALIGN_EPI = false, bool SP2 = false, bool PRELOADED = false>
__device__ __forceinline__ void gemm_phase(PG8_LAS unsigned char* lds, const Gemm g, const Sched& S, const Epi& E, f32x4 (&acc)[2][2][4][2]) {
    const int tid = threadIdx.x, wid = __builtin_amdgcn_readfirstlane(tid >> 6), lane = tid & 63, wr = wid >> 2, wc = wid & 3, fr = lane & 15, fq = lane >> 4;
    const int K = g.K, nt = K / BK;
    unsigned voffA[2], voffB[2];
#pragma unroll
    for (int i = 0; i < 2; ++i) { int R, C; stage_rc(tid * 16 + i * 8192, R, C); const int Rb = Epi::PERM ? ((R & ~31) + perm32(R & 31)) : R;
        voffA[i] = (unsigned)(R * K + C) * 2u; voffB[i] = (unsigned)(Rb * K + C) * 2u; }
    const size_t kstep = (size_t)(BK * 2);
    const size_t hstep = (size_t)HALF * K * 2;
    const size_t tstep = 2 * hstep;
    const unsigned ldsw = (unsigned)wid * 1024u;
    const int aoff = lds_byte(wr * 64 + fr, fq * 8), boff = lds_byte(wc * 32 + fr, fq * 8);
#define PG8_SA(b, h) (((b) * 2 + (h)) * HTB)
#define PG8_SB(b, h) ((4 + (b) * 2 + (h)) * HTB)
#define PG8_STAGE(bufoff, gbase, voff) do { _Pragma("unroll") for (int _i = 0; _i < 2; ++_i) \
        __builtin_amdgcn_global_load_lds((const unsigned*)((const char*)(gbase) + (voff)[_i]), (PG8_LAS unsigned*)(lds + (bufoff) + ldsw + _i * 8192), 16, 0, 0); } while (0)
#define PG8_LDA(dst, b, h) do { _Pragma("unroll") for (int m = 0; m < 4; ++m) _Pragma("unroll") for (int k = 0; k < 2; ++k) dst[m][k] = *(const PG8_LAS bf16x8*)(lds + PG8_SA(b, h) + aoff + m * 2048 + k * 1024); } while (0)
#define PG8_LDB(dst, b, h) do { _Pragma("unroll") for (int n = 0; n < 2; ++n) _Pragma("unroll") for (int k = 0; k < 2; ++k) dst[n][k] = *(const PG8_LAS bf16x8*)(lds + PG8_SB(b, h) + boff + n * 2048 + k * 1024); } while (0)
#define PG8_MMA(ai, bj, At, Bt) do { __builtin_amdgcn_s_setprio(1); _Pragma("unroll") for (int m = 0; m < 4; ++m) _Pragma("unroll") for (int n = 0; n < 2; ++n) _Pragma("unroll") for (int k = 0; k < 2; ++k) \
        acc[ai][bj][m][n] = __builtin_amdgcn_mfma_f32_16x16x32_bf16(Bt[n][k], At[m][k], acc[ai][bj][m][n], 0, 0, 0); __builtin_amdgcn_s_setprio(0); } while (0)
#define PG8_WAIT_V(n) asm volatile("s_waitcnt vmcnt(" #n ")" ::: "memory")
#define PG8_WAIT_L(n) asm volatile("s_waitcnt lgkmcnt(" #n ")" ::: "memory")
#define PG8_BAR __builtin_amdgcn_s_barrier()
#define PG8_SCHED __builtin_amdgcn_sched_barrier(0)
    Unit cur, nxt; int ui = 0;
    if (!S.next(0, cur)) return;
    if constexpr (!PRELOADED) {
#pragma unroll
    for (int a = 0; a < 2; ++a)
#pragma unroll
        for (int b = 0; b < 2; ++b)
#pragma unroll
            for (int m = 0; m < 4; ++m)
#pragma unroll
                for (int n = 0; n < 2; ++n) acc[a][b][m][n] = (f32x4){0.f, 0.f, 0.f, 0.f};
    }
    bf16x8 At[4][2], B0[2][2], B1[2][2];
    const char* cA = (const char*)g.A + (size_t)cur.pm * tstep; const char* cB = (const char*)g.Bt + (size_t)cur.pn * tstep;
    S.a_ready(cur);
    if constexpr (SP2) {
        PG8_STAGE(PG8_SB(0, 0), cB, voffB); PG8_STAGE(PG8_SB(0, 1), cB + hstep, voffB); PG8_STAGE(PG8_SA(0, 0), cA, voffA); PG8_STAGE(PG8_SA(0, 1), cA + hstep, voffA);
        if (wr == 1) PG8_BAR;
        PG8_WAIT_V(2); PG8_BAR;
        PG8_STAGE(PG8_SB(1, 0), cB + kstep, voffB); PG8_STAGE(PG8_SA(1, 0), cA + kstep, voffA); PG8_STAGE(PG8_SB(1, 1), cB + hstep + kstep, voffB);
        PG8_WAIT_V(6); PG8_BAR;
    } else {
        PG8_STAGE(PG8_SB(0, 0), cB, voffB); PG8_STAGE(PG8_SA(0, 0), cA, voffA); PG8_STAGE(PG8_SB(0, 1), cB + hstep, voffB); PG8_STAGE(PG8_SA(0, 1), cA + hstep, voffA);
        if (wr == 1) PG8_BAR;
        PG8_WAIT_V(4); PG8_BAR;
        PG8_STAGE(PG8_SB(1, 0), cB + kstep, voffB); PG8_STAGE(PG8_SA(1, 0), cA + kstep, voffA); PG8_STAGE(PG8_SB(1, 1), cB + hstep + kstep, voffB);
        PG8_WAIT_V(6); PG8_BAR;
    }
    for (;;) {
        const bool has_next = S.next(ui + 1, nxt);
        const char* nA = has_next ? (const char*)g.A + (size_t)nxt.pm * tstep : cA; const char* nB = has_next ? (const char*)g.Bt + (size_t)nxt.pn * tstep : cB;
        for (int t = 0; t < nt; t += 2) {
            const bool last = (t == nt - 2);
            const char* a1 = cA + (size_t)(t + 1) * kstep;
            const char* a2 = last ? nA : cA + (size_t)(t + 2) * kstep; const char* b2 = last ? nB : cB + (size_t)(t + 2) * kstep;
            const char* a3 = a2 + kstep; const char* b3 = b2 + kstep;
            if (last && has_next) S.a_ready(nxt);
            if constexpr (SP2) {
            PG8_LDB(B0, 0, 0); PG8_LDB(B1, 0, 1); PG8_SCHED; PG8_LDA(At, 0, 0); PG8_STAGE(PG8_SA(1, 1), a1 + hstep, voffA);
            PG8_WAIT_V(8); PG8_WAIT_L(0); PG8_BAR; PG8_MMA(0, 0, At, B0); PG8_MMA(0, 1, At, B1); PG8_BAR; PG8_SCHED;
            PG8_LDA(At, 0, 1); PG8_STAGE(PG8_SB(0, 0), b2, voffB); PG8_STAGE(PG8_SB(0, 1), b2 + hstep, voffB); PG8_STAGE(PG8_SA(0, 0), a2, voffA);
            PG8_WAIT_V(8); PG8_WAIT_L(0); PG8_BAR; PG8_MMA(1, 0, At, B0); PG8_MMA(1, 1, At, B1); PG8_BAR; PG8_SCHED;
            PG8_LDB(B0, 1, 0); PG8_LDB(B1, 1, 1); PG8_SCHED; PG8_LDA(At, 1, 0); PG8_STAGE(PG8_SA(0, 1), a2 + hstep, voffA);
            PG8_WAIT_V(8); PG8_WAIT_L(0); PG8_BAR; PG8_MMA(0, 0, At, B0); PG8_MMA(0, 1, At, B1); PG8_BAR; PG8_SCHED;
            PG8_LDA(At, 1, 1); PG8_STAGE(PG8_SB(1, 0), b3, voffB); PG8_STAGE(PG8_SB(1, 1), b3 + hstep, voffB); PG8_STAGE(PG8_SA(1, 0), a3, voffA);
            PG8_WAIT_V(8); PG8_WAIT_L(0); PG8_BAR; PG8_MMA(1, 0, At, B0); PG8_MMA(1, 1, At, B1); PG8_BAR; PG8_SCHED;
            } else {
            PG8_LDB(B0, 0, 0); PG8_SCHED; PG8_LDA(At, 0, 0); PG8_STAGE(PG8_SA(1, 1), a1 + hstep, voffA);
            PG8_WAIT_L(8); PG8_BAR; PG8_WAIT_L(0); PG8_MMA(0, 0, At, B0); PG8_BAR; PG8_SCHED;
            PG8_LDB(B1, 0, 1); PG8_STAGE(PG8_SB(0, 0), b2, voffB);
            PG8_BAR; PG8_WAIT_L(0); PG8_MMA(0, 1, At, B1); PG8_BAR;
            PG8_LDA(At, 0, 1); PG8_STAGE(PG8_SA(0, 0), a2, voffA);
            PG8_BAR; PG8_WAIT_L(0); PG8_MMA(1, 0, At, B0); PG8_BAR; PG8_SCHED;
            PG8_STAGE(PG8_SB(0, 1), b2 + hstep, voffB);
            PG8_WAIT_V(6); PG8_BAR; PG8_MMA(1, 1, At, B1); PG8_BAR;
            PG8_LDB(B0, 1, 0); PG8_SCHED; PG8_LDA(At, 1, 0); PG8_STAGE(PG8_SA(0, 1), a2 + hstep, voffA);
            PG8_WAIT_L(8); PG8_BAR; PG8_WAIT_L(0); PG8_MMA(0, 0, At, B0); PG8_BAR; PG8_SCHED;
            PG8_LDB(B1, 1, 1); PG8_STAGE(PG8_SB(1, 0), b3, voffB);
            PG8_BAR; PG8_WAIT_L(0); PG8_MMA(0, 1, At, B1); PG8_BAR;
            PG8_LDA(At, 1, 1); PG8_STAGE(PG8_SA(1, 0), a3, voffA);
            PG8_BAR; PG8_WAIT_L(0); PG8_MMA(1, 0, At, B0); PG8_BAR; PG8_SCHED;
            PG8_STAGE(PG8_SB(1, 1), b3 + hstep, voffB);
            PG8_WAIT_V(6); PG8_BAR; PG8_MMA(1, 1, At, B1); PG8_BAR;
            }
        }
        if constexpr (ALIGN_EPI) { if (wr == 0) PG8_BAR; }
        if constexpr (!Epi::AFTER_DRAIN) { E(acc, cur, wr, wc, fr, fq); S.done(cur); }
        if (!has_next) break;
#pragma unroll
        for (int a = 0; a < 2; ++a)
#pragma unroll
            for (int b = 0; b < 2; ++b)
#pragma unroll
                for (int m = 0; m < 4; ++m)
#pragma unroll
                    for (int n = 0; n < 2; ++n) acc[a][b][m][n] = (f32x4){0.f, 0.f, 0.f, 0.f};
        cur = nxt; cA = nA; cB = nB; ++ui;
        if constexpr (ALIGN_EPI) { if (wr == 1) PG8_BAR; }
    }
    PG8_WAIT_V(0);
    if constexpr (!ALIGN_EPI) { if (wr == 0) PG8_BAR; }
    PG8_BAR;
    if constexpr (Epi::AFTER_DRAIN) { E.fused(acc, cur, wr, wc, fr, fq, lds, wid, lane); S.done(cur); }
#undef PG8_SA
#undef PG8_SB
#undef PG8_STAGE
#undef PG8_LDA
#undef PG8_LDB
#undef PG8_MMA
#undef PG8_WAIT_V
#undef PG8_WAIT_L
#undef PG8_BAR
#undef PG8_SCHED
}
}

#define LAS __attribute__((address_space(3)))
typedef unsigned short bf16_t;
typedef short bf16x8 __attribute__((ext_vector_type(8)));
typedef short s16x4 __attribute__((ext_vector_type(4)));
typedef float f32x4 __attribute__((ext_vector_type(4)));
typedef float f32x16 __attribute__((ext_vector_type(16)));
typedef unsigned u32x4 __attribute__((ext_vector_type(4)));
typedef unsigned u32x2 __attribute__((ext_vector_type(2)));
using pg8::pk2;

constexpr int M = 16384, D = 1024, SEQ = 2048, FF = 4096, NPROJ = 3072, INW = 3080;
constexpr size_t MiB = 1u << 20;
constexpr size_t WS_WIN = 0, WS_WOUT = 6 * MiB, WS_WUP = 8 * MiB, WS_WDOWN = 16 * MiB, WS_ROPE = 24 * MiB, WS_DT = WS_ROPE + 512 * 1024, WS_ACS = 25 * MiB,
                 WS_PART = WS_ACS + 512 * 1024, WS_LP = WS_PART + MiB, WS_MIX = 28 * MiB, WS_CS = 60 * MiB, WS_X1B = 60 * MiB, WS_SIN = 92 * MiB,
                 WS_BIG = 108 * MiB, WS_H = WS_BIG, WS_XBCC = WS_BIG, WS_PROJ = WS_BIG + 32 * MiB, WS_ACT = WS_BIG, WS_CC = 236 * MiB  , WS_RS = 244 * MiB  , WS_BAR = 245 * MiB  , WS_END = 246 * MiB;
constexpr int LDS_BYTES = 143360;
constexpr int NPHASE = 8;
#ifndef MK_SPLIT
#define MK_SPLIT 0
#endif

#define REP(k) for (int rep_ = 0; rep_ < 1 + ((MK_REPEAT >> (k)) & 1); ++rep_)
#define LDS_WAIT() asm volatile("s_waitcnt lgkmcnt(0)" ::: "memory")
#define LDS_BARRIER() do { asm volatile("s_waitcnt lgkmcnt(0)" ::: "memory"); __builtin_amdgcn_s_barrier(); asm volatile("" ::: "memory"); } while (0)
__device__ __forceinline__ float bflo(unsigned w) { return __uint_as_float(w << 16); }
__device__ __forceinline__ float bfhi(unsigned w) { return __uint_as_float(w & 0xffff0000u); }
__device__ __forceinline__ float wave_sum(float v) {
#pragma unroll
    for (int o = 1; o < 64; o <<= 1) v += __shfl_xor(v, o);
    return v;
}
__device__ __forceinline__ f32x16 mfma32(bf16x8 a, bf16x8 b, f32x16 c) { return __builtin_amdgcn_mfma_f32_32x32x16_bf16(a, b, c, 0, 0, 0); }
__device__ __forceinline__ s16x4 trd(const LAS unsigned char* p) { return __builtin_bit_cast(s16x4, __builtin_amdgcn_ds_read_tr16_b64_v4i16((LAS s16x4*)p)); }
__device__ __forceinline__ bf16x8 cat8(s16x4 lo, s16x4 hi) { return (bf16x8){lo[0], lo[1], lo[2], lo[3], hi[0], hi[1], hi[2], hi[3]}; }
__device__ __forceinline__ float silu_f(float v) { return v / (1.0f + __expf(-v)); }

#define XB_TMO      128
#define XB_XCNT(j)  (256  + 64 * (j))
#define XB_XSUB(j)  (1280 + 64 * (j))
#define XB_XGEN(j)  (2304 + 64 * (j))
#define XB_TOP      3328
#define XB_TOPGEN   3392
#define XCD_BAR_WORDS 3456
#define XB_SPIN_CAP (1u << 18)

__device__ __forceinline__ unsigned xb_ld(unsigned* p)              { return __hip_atomic_load(p, __ATOMIC_RELAXED, __HIP_MEMORY_SCOPE_AGENT); }
__device__ __forceinline__ unsigned xb_add(unsigned* p, unsigned v) { return __hip_atomic_fetch_add(p, v, __ATOMIC_RELAXED, __HIP_MEMORY_SCOPE_AGENT); }
__device__ __forceinline__ unsigned xb_xcc_id() { return (unsigned)__builtin_amdgcn_s_getreg((3 << 11) | 20) & 0xFu; }
#define XB_SPIN(cond, bar) do { unsigned _sp = 0; while (cond) { __builtin_amdgcn_s_sleep(1); \
    if ((++_sp & 255u) == 0u) { if (xb_ld(&(bar)[XB_TMO])) break; if (_sp > XB_SPIN_CAP) { atomicAdd(&(bar)[XB_TMO], 1u); break; } } } } while (0)

struct XcdBarrier {
    unsigned* bar; unsigned x;
    volatile LAS unsigned* st;
};

__device__ __forceinline__ XcdBarrier xcd_barrier_post(unsigned* bar, volatile LAS unsigned* st) {
    XcdBarrier b; b.bar = bar; b.x = xb_xcc_id(); b.st = st;
    if (threadIdx.x == 0) (void)xb_add(&bar[XB_XCNT(b.x)], 1u);
    return b;
}
__device__ __forceinline__ void xcd_barrier_complete(unsigned* bar, unsigned x, unsigned& nloc, unsigned& nx) {
    const unsigned G = gridDim.x * gridDim.y * gridDim.z;
    unsigned sum, cnt, mine, sp = 0u;
    for (;;) {
        sum = 0u; cnt = 0u; mine = 0u;
#pragma unroll
        for (unsigned j = 0; j < 16; ++j) { const unsigned c = xb_ld(&bar[XB_XCNT(j)]); sum += c; cnt += (c > 0u) ? 1u : 0u; mine = (j == x) ? c : mine; }
        if (sum == G) break;
        __builtin_amdgcn_s_sleep(1);
        if ((++sp & 255u) == 0u) { if (xb_ld(&bar[XB_TMO])) break; if (sp > XB_SPIN_CAP) { atomicAdd(&bar[XB_TMO], 1u); break; } }
    }
    nloc = mine > 0u ? mine : 1u; nx = cnt > 0u ? cnt : 1u;
}

__device__ __forceinline__ void xcd_barrier_leader(const XcdBarrier& b) {
        unsigned* bar = b.bar;
        __builtin_amdgcn_s_waitcnt(0);
        unsigned nloc = b.st[0], nx = b.st[1];
        if (nloc == 0u) { xcd_barrier_complete(bar, b.x, nloc, nx); b.st[0] = nloc; b.st[1] = nx; }
        const unsigned old = xb_add(&bar[XB_XSUB(b.x)], 1u);
        const unsigned gen = old / nloc;
        if (old + 1u == (gen + 1u) * nloc) {
            __builtin_amdgcn_fence(__ATOMIC_RELEASE, "agent");
            asm volatile("s_waitcnt vmcnt(0)" ::: "memory");
            const unsigned og = xb_add(&bar[XB_TOP], 1u);
            const unsigned tg = og / nx;
            if (og + 1u == (tg + 1u) * nx) xb_add(&bar[XB_TOPGEN], 1u);
            else XB_SPIN(xb_ld(&bar[XB_TOPGEN]) == tg, bar);
            __builtin_amdgcn_fence(__ATOMIC_ACQUIRE, "agent");
            asm volatile("s_waitcnt vmcnt(0)" ::: "memory");
        } else {
            XB_SPIN(xb_ld(&bar[XB_TOPGEN]) == gen, bar);
            __builtin_amdgcn_fence(__ATOMIC_ACQUIRE, "agent");
            asm volatile("s_waitcnt vmcnt(0)" ::: "memory");
        }
}
__device__ __forceinline__ void xcd_barrier(const XcdBarrier& b) {
    asm volatile("s_waitcnt vmcnt(0)" ::: "memory");
    __syncthreads();
    if (threadIdx.x == 0) xcd_barrier_leader(b);
    __syncthreads();
}


struct Ctx {
    const float *x, *attn_norm_w, *w_in, *q_norm_w, *k_norm_w, *conv_w, *conv_b, *dt_bias, *a_log, *d_skip, *ssd_norm_w, *w_out, *mlp_norm_w, *w_up, *w_down;
    float* out; unsigned char* ws;
    bf16_t *Win, *Wout, *Wup, *Wdown, *H, *XBCC, *PROJ, *ACT, *MIX, *X1B, *SIN, *OP;
    float *ROPEC, *ROPES, *DT, *ACS, *PART, *LP, *RS; bf16_t *CS, *CC;
    LAS unsigned char* lds; int tid, lane, wave, G;
};

__device__ __forceinline__ void p0_transpose_tile(const Ctx& F, const float* W, int ldn, int K, bf16_t* WT, int k0, int n0, int ncols, bool perm, const float* kscale) {
    LAS float* tile = (LAS float*)F.lds;
    f32x4 tv[8];
#pragma unroll
    for (int i = 0; i < 8; ++i) tv[i] = (4 * F.lane < ncols) ? *(const f32x4*)(W + (size_t)(k0 + F.wave * 8 + i) * ldn + n0 + 4 * F.lane) : (f32x4){0.f, 0.f, 0.f, 0.f};
    if (kscale) {
#pragma unroll
        for (int i = 0; i < 8; ++i) tv[i] = tv[i] * kscale[k0 + F.wave * 8 + i]; }
#pragma unroll
    for (int i = 0; i < 8; ++i) *(LAS f32x4*)(tile + (F.wave * 8 + i) * 260 + 4 * F.lane) = tv[i];
    LDS_BARRIER();
#pragma unroll
    for (int j = 0; j < 4; ++j) { const int n = F.lane + 64 * j; if (n < ncols) { const LAS float* sp = tile + (8 * F.wave) * 260 + n;
        u32x4 o; o.x = pk2(sp[0 * 260], sp[1 * 260]); o.y = pk2(sp[2 * 260], sp[3 * 260]); o.z = pk2(sp[4 * 260], sp[5 * 260]); o.w = pk2(sp[6 * 260], sp[7 * 260]);
        const int ng = n0 + n; const int orow = perm ? ((ng & ~255) + 128 * ((ng >> 5) & 1) + 32 * ((ng >> 6) & 3) + (ng & 31)) : ng;
        *(u32x4*)(WT + (size_t)orow * K + k0 + 8 * F.wave) = o; } }
    LDS_BARRIER();
}

__device__ __forceinline__ void p0_transpose_item(const float* W, int ldn, int K, bf16_t* WT, int out_row0, int k0, int n0, const float* kscale, LAS float* scr, int lane) {
    float tv[32];
#pragma unroll
    for (int i = 0; i < 32; ++i) { const int kk = 2 * i + (lane >> 5); tv[i] = W[(size_t)(k0 + kk) * ldn + n0 + (lane & 31)]; }
    if (kscale) {
#pragma unroll
        for (int i = 0; i < 32; ++i) tv[i] *= kscale[k0 + 2 * i + (lane >> 5)]; }
#pragma unroll
    for (int i = 0; i < 32; ++i) scr[(2 * i + (lane >> 5)) * 33 + (lane & 31)] = tv[i];
    LDS_WAIT();
    const int c = lane & 7;
#pragma unroll
    for (int j = 0; j < 4; ++j) { const int n = (lane >> 3) + 8 * j; const LAS float* s = scr + (8 * c) * 33 + n;
        u32x4 o; o.x = pk2(s[0 * 33], s[1 * 33]); o.y = pk2(s[2 * 33], s[3 * 33]); o.z = pk2(s[4 * 33], s[5 * 33]); o.w = pk2(s[6 * 33], s[7 * 33]);
        *(u32x4*)(WT + (size_t)(out_row0 + n) * K + k0 + 8 * c) = o; }
    LDS_WAIT();
}


constexpr int SH_OUT = 16 * 32, SH_UP = 16 * 128, SH_DOWN = 64 * 32, SH_ITEMS = SH_OUT + SH_UP + SH_DOWN, SH_PER_SEAM = SH_ITEMS / 3;
__device__ __forceinline__ void shadow_weight_item(const Ctx& F, int it) {
    LAS float* scr = (LAS float*)(F.lds + F.wave * 8448);
    int r = it;
    if (r < SH_OUT) { const int kb = r / 32, nb = r % 32; p0_transpose_item(F.w_out, D, D, F.Wout, 32 * nb, 64 * kb, 32 * nb, nullptr, scr, F.lane); return; }
    r -= SH_OUT;
    if (r < SH_UP) { const int kb = r / 128, nb = r % 128; p0_transpose_item(F.w_up, FF, D, F.Wup, 32 * nb, 64 * kb, 32 * nb, F.mlp_norm_w, scr, F.lane); return; }
    r -= SH_UP;
    { const int kb = r / 32, nb = r % 32; p0_transpose_item(F.w_down, D, FF, F.Wdown, 32 * nb, 64 * kb, 32 * nb, nullptr, scr, F.lane); }
}
__device__ __forceinline__ void shadow_weights(const Ctx& F, int seam) {
    if (F.wave == 0) return;
    const int nsw = F.G * 7;
    for (int i = blockIdx.x * 7 + (F.wave - 1); i < SH_PER_SEAM; i += nsw) shadow_weight_item(F, seam * SH_PER_SEAM + i);
}

__device__ __forceinline__ void p0_prologue(const Ctx& F) {
    const int gw = blockIdx.x * 8 + F.wave, NGW = F.G * 8;
    constexpr int I_IN = 16 * 16;
    for (int it = blockIdx.x; it < I_IN; it += F.G) p0_transpose_tile(F, F.w_in, INW, D, F.Win, 64 * (it / 16), 192 * (it % 16), 192, true, nullptr);
    for (int idx = blockIdx.x * 512 + F.tid; idx < SEQ * 32; idx += F.G * 512) {
        const int t = idx >> 5, d = idx & 31;
        double p = 1.0; for (int i = 0; i < d; ++i) p *= 0.74989420933245582730;
        const float invf = (float)p, ang = (float)t * invf;
        const double r = (double)ang, k = __builtin_rint(r * 0.63661977236758134308);
        double rr = __builtin_fma(-k, 1.57079632679489655800, r); rr = __builtin_fma(-k, 6.123233995736766036e-17, rr);
        const double r2 = rr * rr;
        const double sp = rr * (1.0 + r2 * (-1.0 / 6 + r2 * (1.0 / 120 + r2 * (-1.0 / 5040 + r2 * (1.0 / 362880 + r2 * (-1.0 / 39916800 + r2 * (1.0 / 6227020800.0)))))));
        const double cp = 1.0 + r2 * (-0.5 + r2 * (1.0 / 24 + r2 * (-1.0 / 720 + r2 * (1.0 / 40320 + r2 * (-1.0 / 3628800 + r2 * (1.0 / 479001600.0 + r2 * (-1.0 / 87178291200.0)))))));
        const int qd = ((int)k) & 3;
        const double sv = (qd == 0) ? sp : (qd == 1) ? cp : (qd == 2) ? -sp : -cp;
        const double cv = (qd == 0) ? cp : (qd == 1) ? -sp : (qd == 2) ? -cp : sp;
        F.ROPEC[idx] = (float)cv; F.ROPES[idx] = (float)sv;
    }
    REP(9) {
        f32x4 wd[4][4][2];
#pragma unroll
        for (int j = 0; j < 4; ++j)
#pragma unroll
            for (int e = 0; e < 4; ++e) { const float* wp = F.w_in + (size_t)(4 * F.lane + 256 * j + e) * INW + NPROJ; wd[j][e][0] = *(const f32x4*)wp; wd[j][e][1] = *(const f32x4*)(wp + 4); }
        const int qsel = 4 * (F.lane & 1) + 2 * ((F.lane >> 1) & 1) + ((F.lane >> 2) & 1);
        const float dtb = F.dt_bias[qsel];
        f32x4 v[4];
        if (gw < M) {
#pragma unroll
            for (int j = 0; j < 4; ++j) v[j] = ((const f32x4*)(F.x + (size_t)gw * D))[F.lane + 64 * j]; }
        for (int m = gw; m < M; m += NGW) {
            f32x4 vn[4]; const int mn = (m + NGW < M) ? m + NGW : m;
#pragma unroll
            for (int j = 0; j < 4; ++j) vn[j] = ((const f32x4*)(F.x + (size_t)mn * D))[F.lane + 64 * j];
            float ss = 0.f;
#pragma unroll
            for (int j = 0; j < 4; ++j) ss += (v[j][0] * v[j][0] + v[j][1] * v[j][1]) + (v[j][2] * v[j][2] + v[j][3] * v[j][3]);
            const float rstd = rsqrtf(wave_sum(ss) * (1.0f / D) + 1e-6f);
            if (F.lane == 0) F.RS[m] = rstd;
            typedef float f32x2v __attribute__((ext_vector_type(2)));
            f32x2v ac2[4];
#pragma unroll
            for (int q = 0; q < 4; ++q) ac2[q] = (f32x2v){0.f, 0.f};
            u32x2* o8 = (u32x2*)(F.H + (size_t)m * D) + F.lane;
#pragma unroll
            for (int j = 0; j < 4; ++j) {
                const f32x4 h = v[j] * rstd * ((const f32x4*)F.attn_norm_w)[F.lane + 64 * j];
                u32x2 o; o.x = pk2(h[0], h[1]); o.y = pk2(h[2], h[3]); o8[64 * j] = o;
#pragma unroll
                for (int e = 0; e < 4; ++e) { const f32x4 w0 = wd[j][e][0], w1 = wd[j][e][1]; const f32x2v hh2 = (f32x2v){h[e], h[e]};
                    ac2[0] += hh2 * (f32x2v){w0[0], w0[1]}; ac2[1] += hh2 * (f32x2v){w0[2], w0[3]};
                    ac2[2] += hh2 * (f32x2v){w1[0], w1[1]}; ac2[3] += hh2 * (f32x2v){w1[2], w1[3]}; }
            }
            const float acc[8] = {ac2[0][0], ac2[0][1], ac2[1][0], ac2[1][1], ac2[2][0], ac2[2][1], ac2[3][0], ac2[3][1]};
            float t4[4], t2[2], t1;
            { const bool b = (F.lane & 1) != 0;
#pragma unroll
              for (int i = 0; i < 4; ++i) { const float send = b ? acc[i] : acc[i + 4], keep = b ? acc[i + 4] : acc[i]; t4[i] = keep + __shfl_xor(send, 1); } }
            { const bool b = (F.lane & 2) != 0;
#pragma unroll
              for (int i = 0; i < 2; ++i) { const float send = b ? t4[i] : t4[i + 2], keep = b ? t4[i + 2] : t4[i]; t2[i] = keep + __shfl_xor(send, 2); } }
            { const bool b = (F.lane & 4) != 0; const float send = b ? t2[0] : t2[1], keep = b ? t2[1] : t2[0]; t1 = keep + __shfl_xor(send, 4); }
            t1 += __shfl_xor(t1, 8); t1 += __shfl_xor(t1, 16); t1 += __shfl_xor(t1, 32);
            if (F.lane < 8) { const float z = t1 + dtb; const float sp = (z > 20.f) ? z : log1pf(__expf(z)); F.DT[(size_t)m * 8 + qsel] = sp; }
#pragma unroll
            for (int j = 0; j < 4; ++j) v[j] = vn[j];
        }
    }
}

__device__ __forceinline__ void ssda_unit(const Ctx& F, int u) {
    const int g = u & 1, c = (u >> 1) & 15, b = u >> 5; const size_t row0 = (size_t)b * SEQ + c * 128;
    LAS unsigned char* lds = F.lds; const int lane = F.lane;
    LAS unsigned char* bimg = lds + 65536; LAS unsigned char* cimg = lds + 100352;
    LAS float* acs = (LAS float*)(lds + 135168); LAS float* dtl = (LAS float*)(lds + 137216); LAS float* dec = (LAS float*)(lds + 139264);
    if (F.wave < 4) {
        const int head = 4 * g + F.wave; const float a = -__expf(F.a_log[head]); const int l0 = 2 * lane;
        const float d0 = F.DT[(row0 + l0) * 8 + head], d1 = F.DT[(row0 + l0 + 1) * 8 + head]; const float a0 = a * d0, a1 = a * d1; float v = a0 + a1;
#pragma unroll
        for (int o = 1; o < 64; o <<= 1) { const float t = __shfl_up(v, o); if (lane >= o) v += t; }
        const float aend = __shfl(v, 63);
        acs[F.wave * 128 + l0] = v - a1; acs[F.wave * 128 + l0 + 1] = v; dtl[F.wave * 128 + l0] = d0; dtl[F.wave * 128 + l0 + 1] = d1;
        dec[F.wave * 128 + l0] = __expf(aend - (v - a1)); dec[F.wave * 128 + l0 + 1] = __expf(aend - v);
        F.ACS[(row0 + l0) * 8 + head] = v - a1; F.ACS[(row0 + l0 + 1) * 8 + head] = v;
    }
    LDS_BARRIER();
    {
        const int cg8 = F.tid & 63, tg = F.tid >> 6;
        const int ch = cg8 < 32 ? 256 * g + 8 * cg8 : (cg8 < 48 ? 512 + 128 * g + 8 * (cg8 - 32) : 768 + 128 * g + 8 * (cg8 - 48));
        float w0[8], w1[8], w2[8], w3[8], bs[8], u0[8], u1[8], u2[8];
#pragma unroll
        for (int e = 0; e < 8; ++e) { w0[e] = F.conv_w[ch + e]; w1[e] = F.conv_w[1024 + ch + e]; w2[e] = F.conv_w[2048 + ch + e]; w3[e] = F.conv_w[3072 + ch + e]; bs[e] = F.conv_b[ch + e]; }
        const int t0 = c * 128 + 16 * tg;
        const bf16_t* src = F.PROJ + (size_t)b * SEQ * NPROJ + 2048 + ch;
#define CVTROW(dst, r_) do { dst[0] = bflo(r_.x); dst[1] = bfhi(r_.x); dst[2] = bflo(r_.y); dst[3] = bfhi(r_.y); dst[4] = bflo(r_.z); dst[5] = bfhi(r_.z); dst[6] = bflo(r_.w); dst[7] = bfhi(r_.w); } while (0)
        const int xhl = (cg8 >> 3) & 3;
#pragma unroll 1
        for (int hb = 0; hb < 2; ++hb) {
            u32x4 raw[11];
#pragma unroll
            for (int k = 0; k < 11; ++k) { const int tt = t0 + 8 * hb - 3 + k; raw[k] = (tt >= 0) ? *(const u32x4*)(src + (size_t)tt * NPROJ) : (u32x4){0u, 0u, 0u, 0u}; }
            CVTROW(u0, raw[0]); CVTROW(u1, raw[1]); CVTROW(u2, raw[2]);
#pragma unroll
            for (int li = 0; li < 8; ++li) {
                const int l = 16 * tg + 8 * hb + li; float u3[8], y[8];
                CVTROW(u3, raw[li + 3]);
#pragma unroll
                for (int e = 0; e < 8; ++e) { const float sv = bs[e] + w0[e] * u0[e] + w1[e] * u1[e] + w2[e] * u2[e] + w3[e] * u3[e]; y[e] = silu_f(sv); u0[e] = u1[e]; u1[e] = u2[e]; u2[e] = u3[e]; }
                u32x4 o; o.x = pk2(y[0], y[1]); o.y = pk2(y[2], y[3]); o.z = pk2(y[4], y[5]); o.w = pk2(y[6], y[7]);
                if (cg8 < 32) {
                    const float sc = dtl[xhl * 128 + l];
                    u32x4 sx; sx.x = pk2(y[0] * sc, y[1] * sc); sx.y = pk2(y[2] * sc, y[3] * sc); sx.z = pk2(y[4] * sc, y[5] * sc); sx.w = pk2(y[6] * sc, y[7] * sc);
                    const int p = (8 * cg8) & 63;
                    *(LAS u32x4*)(lds + xhl * 16384 + (p >> 5) * 8192 + l * 64 + (p & 31) * 2) = sx;
                } else if (cg8 < 48) {
                    *(LAS u32x4*)(bimg + l * 272 + 16 * (cg8 - 32)) = o;
                } else {
                    *(LAS u32x4*)(cimg + l * 272 + 16 * (cg8 - 48)) = o;
                    *(u32x4*)(F.CC + (row0 + l) * 256 + 128 * g + 8 * (cg8 - 48)) = o;
                }
            }
        }
#undef CVTROW
    }
    LDS_BARRIER();
    {
        const int hl = F.wave >> 1, ph = F.wave & 1, hh = lane >> 5;
        const int trow = 8 * hh + ((lane & 15) >> 2), tcol = 16 * ((lane >> 4) & 1) + 4 * (lane & 3);
        const LAS unsigned char* xa = lds + hl * 16384 + ph * 8192 + trow * 64 + tcol * 2; const LAS unsigned char* ba = bimg + trow * 272 + tcol * 2;
        f32x16 acc[4];
#pragma unroll
        for (int nb = 0; nb < 4; ++nb) acc[nb] = (f32x16){0.f};
#pragma unroll
        for (int ks = 0; ks < 8; ++ks) {
            const s16x4 xlo = trd(xa + ks * 1024), xhi = trd(xa + ks * 1024 + 256);
            const f32x4 dlo = *(const LAS f32x4*)(dec + hl * 128 + 16 * ks + 8 * hh), dhi = *(const LAS f32x4*)(dec + hl * 128 + 16 * ks + 8 * hh + 4);
            u32x4 aw;
            aw.x = pk2(__uint_as_float((unsigned)(unsigned short)xlo[0] << 16) * dlo[0], __uint_as_float((unsigned)(unsigned short)xlo[1] << 16) * dlo[1]);
            aw.y = pk2(__uint_as_float((unsigned)(unsigned short)xlo[2] << 16) * dlo[2], __uint_as_float((unsigned)(unsigned short)xlo[3] << 16) * dlo[3]);
            aw.z = pk2(__uint_as_float((unsigned)(unsigned short)xhi[0] << 16) * dhi[0], __uint_as_float((unsigned)(unsigned short)xhi[1] << 16) * dhi[1]);
            aw.w = pk2(__uint_as_float((unsigned)(unsigned short)xhi[2] << 16) * dhi[2], __uint_as_float((unsigned)(unsigned short)xhi[3] << 16) * dhi[3]);
            const bf16x8 af = __builtin_bit_cast(bf16x8, aw);
#pragma unroll
            for (int nb = 0; nb < 4; ++nb) { const LAS unsigned char* bp = ba + (16 * ks) * 272 + nb * 64; const bf16x8 bf = cat8(trd(bp), trd(bp + 4 * 272)); acc[nb] = mfma32(af, bf, acc[nb]); }
        }
        bf16_t* cs = F.CS + ((size_t)((b * 16 + c) * 8 + 4 * g + hl)) * 8192 + (lane & 31);
#pragma unroll
        for (int nb = 0; nb < 4; ++nb)
#pragma unroll
            for (int i = 0; i < 16; i += 2) { const int p = 32 * ph + (i & 3) + 8 * (i >> 2) + 4 * hh; const unsigned w2 = pk2(acc[nb][i], acc[nb][i + 1]);
                cs[(size_t)p * 128 + 32 * nb] = (bf16_t)(w2 & 0xffffu); cs[(size_t)(p + 1) * 128 + 32 * nb] = (bf16_t)(w2 >> 16); }
    }
    {
        const int hl = F.wave >> 1, head = 4 * g + hl, lq = lane & 31, hh = lane >> 5;
        const float dsk = F.d_skip[head];
        const int tra = (4 * hh + ((lane & 15) >> 2)) * 64 + (16 * ((lane >> 4) & 1) + 4 * (lane & 3)) * 2;
#pragma unroll 1
        for (int lbi = 0; lbi < 2; ++lbi) {
            const int lb = (F.wave & 1) ? (1 + lbi) : (3 * lbi);
            const int l = 32 * lb + lq; const float acl = acs[hl * 128 + l]; const float rdt = 1.0f / dtl[hl * 128 + l];
            bf16x8 cf[8];
#pragma unroll
            for (int ks = 0; ks < 8; ++ks) cf[ks] = *(const LAS bf16x8*)(cimg + l * 272 + (16 * ks + 8 * hh) * 2);
            f32x16 acc[2]; acc[0] = (f32x16){0.f}; acc[1] = (f32x16){0.f};
            for (int sb = 0; sb <= lb; ++sb) {
                f32x16 gt = (f32x16){0.f};
                { const LAS unsigned char* bp = bimg + (32 * sb + lq) * 272 + 16 * hh;
#pragma unroll
                  for (int ks = 0; ks < 8; ++ks) gt = mfma32(*(const LAS bf16x8*)(bp + 32 * ks), cf[ks], gt); }
                float pg[16];
#pragma unroll
                for (int i = 0; i < 16; ++i) { const int sl = (i & 3) + 8 * (i >> 2) + 4 * hh; const float e = __expf(acl - acs[hl * 128 + 32 * sb + sl]);
                    pg[i] = (sb < lb || sl <= lq) ? gt[i] * e : 0.f; }
                bf16x8 pf0, pf1;
                { u32x4 a4; a4.x = pk2(pg[0], pg[1]); a4.y = pk2(pg[2], pg[3]); a4.z = pk2(pg[4], pg[5]); a4.w = pk2(pg[6], pg[7]); pf0 = __builtin_bit_cast(bf16x8, a4);
                  u32x4 d4; d4.x = pk2(pg[8], pg[9]); d4.y = pk2(pg[10], pg[11]); d4.z = pk2(pg[12], pg[13]); d4.w = pk2(pg[14], pg[15]); pf1 = __builtin_bit_cast(bf16x8, d4); }
                const LAS unsigned char* xb = lds + hl * 16384 + (32 * sb) * 64 + tra;
#pragma unroll
                for (int ph = 0; ph < 2; ++ph) { const LAS unsigned char* xp = xb + ph * 8192;
                    acc[ph] = mfma32(cat8(trd(xp), trd(xp + 512)), pf0, acc[ph]); acc[ph] = mfma32(cat8(trd(xp + 1024), trd(xp + 1536)), pf1, acc[ph]); }
            }
            const LAS unsigned char* xp = lds + hl * 16384 + l * 64 + 8 * hh; bf16_t* op = F.MIX + (row0 + l) * 1024 + 512 + 256 * g + 64 * hl + 4 * hh;
#pragma unroll
            for (int ph = 0; ph < 2; ++ph)
#pragma unroll
                for (int k4 = 0; k4 < 4; ++k4) { const u32x2 xw = *(const LAS u32x2*)(xp + ph * 8192 + 16 * k4);
                    const float xs[4] = {bflo(xw.x), bfhi(xw.x), bflo(xw.y), bfhi(xw.y)};
                    u32x2 o; o.x = pk2(acc[ph][4 * k4] + dsk * (xs[0] * rdt), acc[ph][4 * k4 + 1] + dsk * (xs[1] * rdt)); o.y = pk2(acc[ph][4 * k4 + 2] + dsk * (xs[2] * rdt), acc[ph][4 * k4 + 3] + dsk * (xs[3] * rdt));
                    *(u32x2*)(op + 32 * ph + 8 * k4) = o; }
        }
    }
    LDS_BARRIER();
}

struct AU { int b, h, br, dsh, grp; };
__device__ __forceinline__ AU au_decode(int u) { AU a; a.grp = u & 7; int combo = u >> 3; a.br = combo % 3; combo /= 3; a.h = combo & 7; a.b = combo >> 3; a.dsh = 2 * a.br; return a; }
__device__ __forceinline__ int au_key_token(const AU& a, int j) {
    if (a.br == 2) return (j < 256) ? (2 * a.grp + (j >> 7)) + 16 * (j & 127) : -1;
    const int r = a.br == 0 ? 0 : (a.grp >> 1), base = a.br == 0 ? 256 * a.grp : 256 * (a.grp & 1), idx = base - 128 + j;
    return idx >= 0 ? r + (idx << a.dsh) : -1;
}
__device__ __forceinline__ void au_issue(const Ctx& F, int u, bf16x8 (&kr)[6], bf16x8 (&vr)[6], bf16x8 (&qn)[4]) {
    const AU a = au_decode(u); const int srow = F.tid >> 3, c8 = F.tid & 7, q = F.lane & 31, hh = F.lane >> 5, w = F.wave;
    const bf16_t* base = F.PROJ + (size_t)a.b * SEQ * NPROJ + a.h * 64;
#pragma unroll
    for (int i = 0; i < 6; ++i) { const int tok = au_key_token(a, 64 * i + srow);
        if (tok >= 0) { const bf16_t* p = base + (size_t)tok * NPROJ + 512 + 8 * c8; kr[i] = *(const bf16x8*)p; vr[i] = *(const bf16x8*)(p + 512); }
        else { kr[i] = (bf16x8){0, 0, 0, 0, 0, 0, 0, 0}; vr[i] = kr[i]; } }
    int qtok;
    if (a.br == 2) qtok = (2 * a.grp + (w >> 2)) + 16 * (32 * (w & 3) + q);
    else { const int r = a.br == 0 ? 0 : (a.grp >> 1), bq = a.br == 0 ? 256 * a.grp : 256 * (a.grp & 1); qtok = r + ((bq + 32 * w + q) << a.dsh); }
    const bf16_t* qp = base + (size_t)qtok * NPROJ + 8 * hh;
#pragma unroll
    for (int s = 0; s < 4; ++s) qn[s] = *(const bf16x8*)(qp + 16 * s);
}
__device__ __forceinline__ void attn_phase(const Ctx& F, float ref2) {
    constexpr int NU = 8 * 8 * 3 * 8;
    const int lane = F.lane, w = F.wave, q = lane & 31, hh = lane >> 5, srow = F.tid >> 3, c8 = F.tid & 7;
    LAS unsigned char* kimg = F.lds; LAS unsigned char* vimg = F.lds + 55296; LAS unsigned char* oimg = F.lds + 104448 + w * 4608;
    const int tra = (4 * hh + ((lane & 15) >> 2)) * 64 + (16 * ((lane >> 4) & 1) + 4 * (lane & 3)) * 2;
    bf16x8 kr[6], vr[6], qn[4];
    f32x16 negref;
#pragma unroll
    for (int i = 0; i < 16; ++i) negref[i] = -ref2;
    const bool xcdmap = (F.G % 8) == 0; const int ustep = xcdmap ? F.G / 8 : F.G, ubase = xcdmap ? (int)(blockIdx.x & 7) * (NU / 8) : 0, uend = xcdmap ? NU / 8 : NU;
    int ui = xcdmap ? (int)(blockIdx.x >> 3) : (int)blockIdx.x;
    if (ui < uend) au_issue(F, ubase + ui, kr, vr, qn);
    for (; ui < uend; ui += ustep) {
        const int u = ubase + ui;
        const AU a = au_decode(u);
        bf16x8 qf[4];
#pragma unroll
        for (int s = 0; s < 4; ++s) qf[s] = qn[s];
#pragma unroll
        for (int i = 0; i < 6; ++i) { const int j = 64 * i + srow;
            *(LAS bf16x8*)(kimg + j * 144 + c8 * 16) = kr[i];
            *(LAS bf16x8*)(vimg + (j >> 5) * 4096 + (c8 >> 2) * 2048 + (j & 31) * 64 + (c8 & 3) * 16) = vr[i]; }
        LDS_BARRIER();
        if (ui + ustep < uend) au_issue(F, u + ustep, kr, vr, qn);
        int kt0, st0, i0, qtok0;
        if (a.br == 2) { const int qt = w & 3; kt0 = 4 - qt; st0 = 4 * (w >> 2) + qt - 4; i0 = 32 * qt; qtok0 = 2 * a.grp + (w >> 2); }
        else { const int bq = a.br == 0 ? 256 * a.grp : 256 * (a.grp & 1); const int qtg = (bq >> 5) + w; kt0 = 4 - qtg; if (kt0 < 0) kt0 = 0; st0 = w; i0 = bq + 32 * w; qtok0 = a.br == 0 ? 0 : (a.grp >> 1); }
        f32x16 o0 = (f32x16){0.f}, o1 = (f32x16){0.f}; float lsum = 0.f;
        for (int kt = kt0; kt <= 4; ++kt) {
            const int st = st0 + kt;
            const LAS unsigned char* kp = kimg + (32 * st + q) * 144 + 16 * hh; const LAS unsigned char* vp = vimg + st * 4096 + tra;
            f32x16 sc = negref;
#pragma unroll
            for (int s = 0; s < 4; ++s) sc = mfma32(*(const LAS bf16x8*)(kp + 32 * s), qf[s], sc);
            float p[16];
#pragma unroll
            for (int i = 0; i < 16; ++i) p[i] = __builtin_amdgcn_exp2f(sc[i]);
            if (kt == 0) {
#pragma unroll
                for (int i = 0; i < 16; ++i) { const int kv = (i & 3) + 8 * (i >> 2) + 4 * hh; if (kv < q) p[i] = 0.f; } }
            if (kt == 4) {
#pragma unroll
                for (int i = 0; i < 16; ++i) { const int kv = (i & 3) + 8 * (i >> 2) + 4 * hh; if (kv > q) p[i] = 0.f; } }
#pragma unroll
            for (int i = 0; i < 16; ++i) lsum += p[i];
            bf16x8 pf0, pf1;
            { u32x4 x; x.x = pk2(p[0], p[1]); x.y = pk2(p[2], p[3]); x.z = pk2(p[4], p[5]); x.w = pk2(p[6], p[7]); pf0 = __builtin_bit_cast(bf16x8, x);
              u32x4 y; y.x = pk2(p[8], p[9]); y.y = pk2(p[10], p[11]); y.z = pk2(p[12], p[13]); y.w = pk2(p[14], p[15]); pf1 = __builtin_bit_cast(bf16x8, y); }
            { const bf16x8 a00 = cat8(trd(vp), trd(vp + 512)), a01 = cat8(trd(vp + 1024), trd(vp + 1536));
              const bf16x8 a10 = cat8(trd(vp + 2048), trd(vp + 2048 + 512)), a11 = cat8(trd(vp + 2048 + 1024), trd(vp + 2048 + 1536));
              o0 = mfma32(a00, pf0, o0); o0 = mfma32(a01, pf1, o0); o1 = mfma32(a10, pf0, o1); o1 = mfma32(a11, pf1, o1); }
        }
        lsum += __shfl_xor(lsum, 32);
#pragma unroll
        for (int g4 = 0; g4 < 4; ++g4) {
            u32x2 x; x.x = pk2(o0[4 * g4], o0[4 * g4 + 1]); x.y = pk2(o0[4 * g4 + 2], o0[4 * g4 + 3]); *(LAS u32x2*)(oimg + q * 144 + (8 * g4 + 4 * hh) * 2) = x;
            u32x2 y; y.x = pk2(o1[4 * g4], o1[4 * g4 + 1]); y.y = pk2(o1[4 * g4 + 2], o1[4 * g4 + 3]); *(LAS u32x2*)(oimg + q * 144 + (32 + 8 * g4 + 4 * hh) * 2) = y; }
        LDS_WAIT();
        { const int rowi = lane >> 3, cc = lane & 7;
          bf16_t* op = F.OP + ((size_t)a.br * M + (size_t)a.b * SEQ + qtok0) * 512 + a.h * 64 + 8 * cc;
#pragma unroll
          for (int i = 0; i < 4; ++i) __builtin_nontemporal_store(*(const LAS u32x4*)(oimg + (8 * i + rowi) * 144 + cc * 16), (u32x4*)(op + ((size_t)(i0 + 8 * i + rowi) << a.dsh) * 512)); }
        if (hh == 0) F.LP[((size_t)a.br * M + (size_t)a.b * SEQ + qtok0 + ((size_t)(i0 + q) << a.dsh)) * 8 + a.h] = lsum;
        LDS_BARRIER();
    }
}

__device__ __forceinline__ void p3_scan_merge(const Ctx& F) {
    const int gt = blockIdx.x * 512 + F.tid, NT = F.G * 512;
    for (int idx = gt; idx < 8 * 8 * 64 * 32; idx += NT) {
        const int n4 = idx & 31, p = (idx >> 5) & 63, hd = (idx >> 11) & 7, b = idx >> 14;
        f32x4 st = (f32x4){0.f, 0.f, 0.f, 0.f};
        const size_t off0 = ((size_t)(b * 16 * 8 + hd)) * 8192 + p * 128 + 4 * n4;
        u32x2 cw[15]; float da[15];
#pragma unroll
        for (int c = 0; c < 15; ++c) { cw[c] = __builtin_nontemporal_load((const u32x2*)(F.CS + off0 + (size_t)c * 65536)); da[c] = F.ACS[((size_t)b * SEQ + c * 128 + 127) * 8 + hd]; }
        asm volatile("" ::: "memory");
#pragma unroll
        for (int c = 0; c < 16; ++c) {
            u32x2 o; o.x = pk2(st[0], st[1]); o.y = pk2(st[2], st[3]); *(u32x2*)(F.SIN + off0 + (size_t)c * 65536) = o;
            if (c < 15) st = st * __expf(da[c]) + (f32x4){bflo(cw[c].x), bfhi(cw[c].x), bflo(cw[c].y), bfhi(cw[c].y)};
        }
    }
    for (int it = gt; it < M * 64; it += NT) {
        const int dc = it & 7, h = (it >> 3) & 7; const size_t row = (size_t)(it >> 6);
        float l = 0.f; float o[8];
#pragma unroll
        for (int e = 0; e < 8; ++e) o[e] = 0.f;
#pragma unroll
        for (int br = 0; br < 3; ++br) {
            l += F.LP[((size_t)br * M + row) * 8 + h];
            const u32x4 w = __builtin_nontemporal_load((const u32x4*)(F.OP + ((size_t)br * M + row) * 512 + h * 64 + 8 * dc));
            o[0] += bflo(w.x); o[1] += bfhi(w.x); o[2] += bflo(w.y); o[3] += bfhi(w.y); o[4] += bflo(w.z); o[5] += bfhi(w.z); o[6] += bflo(w.w); o[7] += bfhi(w.w);
        }
        const float inv = 1.0f / l;
        u32x4 r; r.x = pk2(o[0] * inv, o[1] * inv); r.y = pk2(o[2] * inv, o[3] * inv); r.z = pk2(o[4] * inv, o[5] * inv); r.w = pk2(o[6] * inv, o[7] * inv);
        *(u32x4*)(F.MIX + row * 1024 + h * 64 + 8 * dc) = r;
    }
}

__device__ __forceinline__ void ssdb_issue(const Ctx& F, int u, u32x2 (&zr)[2][4], u32x2 (&yr)[2][4], u32x4 (&cr4)[4], float (&eal)[2]) {
    const int g = u & 1, c = (u >> 1) & 15, b = u >> 5; const size_t row0 = (size_t)b * SEQ + c * 128;
    const int hl = F.wave >> 1, head = 4 * g + hl, lq = F.lane & 31, hh = F.lane >> 5;
#pragma unroll
    for (int lbi = 0; lbi < 2; ++lbi) { const int lb = (F.wave & 1) ? (1 + lbi) : (3 * lbi); eal[lbi] = F.ACS[(row0 + 32 * lb + lq) * 8 + head]; }
    {   const int l = 32 * ((F.wave & 1) ? 1 : 0) + lq;
        const bf16_t* op = F.MIX + (row0 + l) * 1024 + 512 + 256 * g + 64 * hl + 4 * hh; const bf16_t* zp = F.PROJ + (row0 + l) * NPROJ + 1536 + 256 * g + 64 * hl + 4 * hh;
#pragma unroll
        for (int ph = 0; ph < 2; ++ph)
#pragma unroll
            for (int k4 = 0; k4 < 4; ++k4) { zr[ph][k4] = *(const u32x2*)(zp + 32 * ph + 8 * k4); yr[ph][k4] = *(const u32x2*)(op + 32 * ph + 8 * k4); }
    }
    const int brow = F.tid >> 4, bcol = 8 * (F.tid & 15);
    const bf16_t* bp = F.CC + (row0 + brow) * 256 + 128 * g + bcol;
#pragma unroll
    for (int i = 0; i < 4; ++i) cr4[i] = *(const u32x4*)(bp + (size_t)(32 * i) * 256);
}
__device__ __forceinline__ void ssdb_unit(const Ctx& F, int u, const u32x2 (&zr)[2][4], const u32x2 (&yr)[2][4], const u32x4 (&cr4)[4], const float (&ealv)[2]) {
    const int g = u & 1, c = (u >> 1) & 15, b = u >> 5; const size_t row0 = (size_t)b * SEQ + c * 128;
    LAS unsigned char* lds = F.lds; const int lane = F.lane;
    LAS unsigned char* cimg = lds; LAS float* ssq = (LAS float*)(lds + 34816);
    const int hl = F.wave >> 1, head = 4 * g + hl, lq = lane & 31, hh = lane >> 5;
    bf16x8 sin[2][8];
    { const bf16_t* sp = F.SIN + ((size_t)((b * 16 + c) * 8 + head)) * 8192 + (size_t)lq * 128 + 8 * hh;
#pragma unroll
      for (int ph = 0; ph < 2; ++ph)
#pragma unroll
          for (int ks = 0; ks < 8; ++ks) sin[ph][ks] = *(const bf16x8*)(sp + (size_t)ph * 32 * 128 + 16 * ks); }
    { const int brow = F.tid >> 4, bcol = 8 * (F.tid & 15);
#pragma unroll
      for (int i = 0; i < 4; ++i) *(LAS u32x4*)(cimg + (brow + 32 * i) * 272 + bcol * 2) = cr4[i]; }
    LDS_BARRIER();
    u32x2 z1[2][4], y1[2][4];
#pragma unroll
    for (int lbi = 0; lbi < 2; ++lbi) {
        const int lb = (F.wave & 1) ? (1 + lbi) : (3 * lbi);
        const int l = 32 * lb + lq;
        const float eal = __expf(ealv[lbi]);
        bf16_t* op = F.MIX + (row0 + l) * 1024 + 512 + 256 * g + 64 * hl + 4 * hh;
        if (lbi == 0) {
            const int l1 = 32 * ((F.wave & 1) ? 2 : 3) + lq;
            const bf16_t* op1 = F.MIX + (row0 + l1) * 1024 + 512 + 256 * g + 64 * hl + 4 * hh; const bf16_t* zp1 = F.PROJ + (row0 + l1) * NPROJ + 1536 + 256 * g + 64 * hl + 4 * hh;
#pragma unroll
            for (int ph = 0; ph < 2; ++ph)
#pragma unroll
                for (int k4 = 0; k4 < 4; ++k4) { z1[ph][k4] = *(const u32x2*)(zp1 + 32 * ph + 8 * k4); y1[ph][k4] = *(const u32x2*)(op1 + 32 * ph + 8 * k4); }
        }
        bf16x8 cf[8];
#pragma unroll
        for (int ks = 0; ks < 8; ++ks) cf[ks] = *(const LAS bf16x8*)(cimg + l * 272 + (16 * ks + 8 * hh) * 2);
        f32x16 acc[2];
#pragma unroll
        for (int ph = 0; ph < 2; ++ph) { f32x16 a = (f32x16){0.f};
#pragma unroll
            for (int ks = 0; ks < 8; ++ks) a = mfma32(sin[ph][ks], cf[ks], a);
            acc[ph] = a * eal; }
        float ss = 0.f;
#pragma unroll
        for (int ph = 0; ph < 2; ++ph)
#pragma unroll
            for (int k4 = 0; k4 < 4; ++k4) { const u32x2 yw = lbi == 0 ? yr[ph][k4] : y1[ph][k4], zw = lbi == 0 ? zr[ph][k4] : z1[ph][k4];
                const float ys[4] = {bflo(yw.x), bfhi(yw.x), bflo(yw.y), bfhi(yw.y)}, zs[4] = {bflo(zw.x), bfhi(zw.x), bflo(zw.y), bfhi(zw.y)};
#pragma unroll
                for (int e = 0; e < 4; ++e) { const float y = (acc[ph][4 * k4 + e] + ys[e]) * silu_f(zs[e]); acc[ph][4 * k4 + e] = y; ss += y * y; } }
        ss += __shfl_xor(ss, 32);
        if (hh == 0) ssq[lbi * 512 + hl * 128 + l] = ss;
        LDS_BARRIER();
        const LAS float* sq = ssq + lbi * 512 + l;
        const float rstd = rsqrtf(((sq[0] + sq[128]) + (sq[256] + sq[384])) * (1.0f / 256.0f) + 1e-6f);
        const float* wp = F.ssd_norm_w + 256 * g + 64 * hl + 4 * hh;
#pragma unroll
        for (int ph = 0; ph < 2; ++ph)
#pragma unroll
            for (int k4 = 0; k4 < 4; ++k4) { const f32x4 w = *(const f32x4*)(wp + 32 * ph + 8 * k4); const f32x16 y = acc[ph];
                u32x2 o; o.x = pk2(y[4 * k4] * rstd * w[0], y[4 * k4 + 1] * rstd * w[1]); o.y = pk2(y[4 * k4 + 2] * rstd * w[2], y[4 * k4 + 3] * rstd * w[3]);
                *(u32x2*)(op + 32 * ph + 8 * k4) = o; }
    }
    LDS_BARRIER();
}

struct Args { const float* in[15]; float* out; unsigned char* ws; int ph_lo, ph_hi; };
__global__ void __launch_bounds__(512) hybrid_fwd(Args args) {
    extern __shared__ __attribute__((aligned(16))) unsigned char lds_raw[];
    Ctx F;
    F.x = args.in[0]; F.attn_norm_w = args.in[1]; F.w_in = args.in[2]; F.q_norm_w = args.in[3]; F.k_norm_w = args.in[4]; F.conv_w = args.in[5]; F.conv_b = args.in[6];
    F.dt_bias = args.in[7]; F.a_log = args.in[8]; F.d_skip = args.in[9]; F.ssd_norm_w = args.in[10]; F.w_out = args.in[11]; F.mlp_norm_w = args.in[12]; F.w_up = args.in[13]; F.w_down = args.in[14];
    F.out = args.out; F.ws = args.ws; unsigned char* ws = args.ws;
    F.Win = (bf16_t*)(ws + WS_WIN); F.Wout = (bf16_t*)(ws + WS_WOUT); F.Wup = (bf16_t*)(ws + WS_WUP); F.Wdown = (bf16_t*)(ws + WS_WDOWN);
    F.H = (bf16_t*)(ws + WS_H); F.XBCC = (bf16_t*)(ws + WS_XBCC); F.PROJ = (bf16_t*)(ws + WS_PROJ); F.ACT = (bf16_t*)(ws + WS_ACT); F.MIX = (bf16_t*)(ws + WS_MIX);
    F.X1B = (bf16_t*)(ws + WS_X1B); F.SIN = (bf16_t*)(ws + WS_SIN); F.OP = (bf16_t*)args.out;
    F.ROPEC = (float*)(ws + WS_ROPE); F.ROPES = F.ROPEC + SEQ * 32; F.DT = (float*)(ws + WS_DT); F.ACS = (float*)(ws + WS_ACS); F.PART = (float*)(ws + WS_PART); F.LP = (float*)(ws + WS_LP); F.CS = (bf16_t*)(ws + WS_CS); F.CC = (bf16_t*)(ws + WS_CC); F.RS = (float*)(ws + WS_RS);
    F.lds = (LAS unsigned char*)lds_raw; F.tid = threadIdx.x; F.lane = F.tid & 63; F.wave = __builtin_amdgcn_readfirstlane(F.tid >> 6); F.G = gridDim.x;
    const int lo = args.ph_lo, hi = args.ph_hi;
#define IN(k) (lo <= (k) && (k) < hi)
#define SEAM(k) do { if (IN(k) && IN((k) + 1)) { xcd_barrier(bar); if ((MK_REPEAT >> 12) & 1) xcd_barrier(bar); } } while (0)
#define SEAM_SHADOW(k, seam, nodrain) do { if (IN(k) && IN((k) + 1)) { asm volatile("s_waitcnt vmcnt(0)" ::: "memory"); __syncthreads(); shadow_weights(F, seam); \
        if (threadIdx.x == 0) xcd_barrier_leader(bar); if (nodrain) LDS_BARRIER(); else __syncthreads(); } else if (IN(k)) { __syncthreads(); shadow_weights(F, seam); } } while (0)
    if (lo > 1000) cg::this_grid().sync();
    volatile LAS unsigned* bst = (volatile LAS unsigned*)(F.lds + LDS_BYTES - 16);
    if (F.tid < 2) bst[F.tid] = 0u;
    __syncthreads();
    XcdBarrier bar = xcd_barrier_post((unsigned*)(ws + WS_BAR), bst);

    if (IN(0)) REP(0) p0_prologue(F);
    SEAM(0);
    if (IN(1)) REP(1) { pg8::Gemm gm{F.H, F.Win, M, NPROJ, D}; pg8::StaticOrder S; S.init(M, NPROJ, F.G, (int)blockIdx.x);
        pg8::EpiInProj E{F.PROJ, F.q_norm_w, F.k_norm_w, F.ROPEC, F.ROPES};
        pg8::f32x4 lacc[2][2][4][2]; pg8::gemm_phase<pg8::EpiInProj, pg8::StaticOrder, true, true>(F.lds, gm, S, E, lacc); }
    SEAM_SHADOW(1, 0, true);
    if (IN(2)) REP(2) {
        for (int u = blockIdx.x; u < 256; u += F.G) ssda_unit(F, u);
        float mq = fabsf(F.q_norm_w[F.lane]), mk = fabsf(F.k_norm_w[F.lane]);
#pragma unroll
        for (int o = 1; o < 64; o <<= 1) { mq = fmaxf(mq, __shfl_xor(mq, o)); mk = fmaxf(mk, __shfl_xor(mk, o)); }
        const float ref2 = pg8::QSCALE * 64.0f * mq * mk;
        REP(11) attn_phase(F, ref2);
    }
    SEAM_SHADOW(2, 1, true);
    if (IN(3)) REP(3) p3_scan_merge(F);
    {
        u32x2 pzr[2][4], pyr[2][4]; u32x4 pcr[4]; float peal[2];
        const bool p4first = IN(4) && (int)blockIdx.x < 256;
        if (IN(3) && IN(4)) {
            asm volatile("s_waitcnt vmcnt(0)" ::: "memory"); __syncthreads();
            if (p4first && F.wave != 0) ssdb_issue(F, blockIdx.x, pzr, pyr, pcr, peal);
            if (threadIdx.x == 0) xcd_barrier_leader(bar);
            LDS_BARRIER();
            if (p4first && F.wave == 0) ssdb_issue(F, blockIdx.x, pzr, pyr, pcr, peal);
        } else if (p4first) ssdb_issue(F, blockIdx.x, pzr, pyr, pcr, peal);
        if (p4first) ssdb_unit(F, blockIdx.x, pzr, pyr, pcr, peal);
        if (IN(4)) {
#pragma unroll 1
            for (int u = blockIdx.x + F.G; u < 256; u += F.G) { ssdb_issue(F, u, pzr, pyr, pcr, peal); ssdb_unit(F, u, pzr, pyr, pcr, peal); } }
    }
    const int pwr = F.wave >> 2, pwc = F.wave & 3, pfr = F.lane & 15, pfq = F.lane >> 4;
    {   pg8::f32x4 gacc[2][2][4][2]; pg8::StaticOrder S; S.init(M, D, F.G, (int)blockIdx.x); pg8::Unit u0; const bool has = IN(5) && S.next(0, u0);
        if (IN(4) && IN(5)) {
            asm volatile("s_waitcnt vmcnt(0)" ::: "memory"); __syncthreads();
            if (has && F.wave != 0) pg8::preload_h_tile(gacc, F.H, F.RS, F.attn_norm_w, u0, pwr, pwc, pfr, pfq);
            if (threadIdx.x == 0) xcd_barrier_leader(bar);
            LDS_BARRIER();
            if (has && F.wave == 0) pg8::preload_h_tile(gacc, F.H, F.RS, F.attn_norm_w, u0, pwr, pwc, pfr, pfq);
        } else if (has) pg8::preload_h_tile(gacc, F.H, F.RS, F.attn_norm_w, u0, pwr, pwc, pfr, pfq);
        if (IN(5)) { pg8::Gemm gm{F.MIX, F.Wout, M, D, D};
            pg8::EpiOutProjPre E{F.X1B, F.PART};
            pg8::gemm_phase<pg8::EpiOutProjPre, pg8::StaticOrder, true, true, true>(F.lds, gm, S, E, gacc); }
    }
    SEAM_SHADOW(5, 2, false);
    if (IN(6)) { pg8::Gemm gm{F.X1B, F.Wup, M, FF, D}; pg8::StaticOrder S; S.init(M, FF, F.G, (int)blockIdx.x);
        LAS float* rt = (LAS float*)(F.lds + 131072 + 2048); int pmc = -1;
        { pg8::Unit u0; if (S.next(0, u0)) { pmc = u0.pm; const float* pp = F.PART + ((size_t)u0.pm * 256 + (F.tid >> 1)) * 16 + 8 * (F.tid & 1);
            const f32x4 a = *(const f32x4*)pp, b = *(const f32x4*)(pp + 4); float sq = ((a[0] + a[1]) + (a[2] + a[3])) + ((b[0] + b[1]) + (b[2] + b[3])); sq += __shfl_xor(sq, 1);
            if (!(F.tid & 1)) rt[F.tid >> 1] = rsqrtf(sq * (1.0f / 1024.0f) + 1e-6f); } }
        __syncthreads();
        pg8::EpiUpT E{F.ACT, F.PART, rt, pmc};
        pg8::f32x4 lacc[2][2][4][2]; pg8::gemm_phase<pg8::EpiUpT, pg8::StaticOrder, true, true>(F.lds, gm, S, E, lacc); }
    {   pg8::f32x4 gacc[2][2][4][2]; pg8::StaticOrder S; S.init(M, D, F.G, (int)blockIdx.x); pg8::Unit u0; const bool has = IN(7) && S.next(0, u0);
        if (IN(6) && IN(7)) {
            asm volatile("s_waitcnt vmcnt(0)" ::: "memory"); __syncthreads();
            if (has && F.wave != 0) pg8::preload_bf16_tile(gacc, F.X1B, u0, pwr, pwc, pfr, pfq);
            if (threadIdx.x == 0) xcd_barrier_leader(bar);
            LDS_BARRIER();
            if (has && F.wave == 0) pg8::preload_bf16_tile(gacc, F.X1B, u0, pwr, pwc, pfr, pfq);
        } else if (has) pg8::preload_bf16_tile(gacc, F.X1B, u0, pwr, pwc, pfr, pfq);
        if (IN(7)) { pg8::Gemm gm{F.ACT, F.Wdown, M, D, FF};
            pg8::EpiDownPre E{F.out};
            pg8::gemm_phase<pg8::EpiDownPre, pg8::StaticOrder, true, true, true>(F.lds, gm, S, E, gacc); }
    }
#undef IN
#undef SEAM
}

extern "C" void kernel_launch(void* const* d_in, const int* in_sizes, int n_in, void* d_out, int out_size, void* d_ws, size_t ws_size, hipStream_t stream) {
    static int grid = 0;
    if (grid == 0) {
        if (n_in != 15 || out_size != M * D || ws_size < WS_END) { fprintf(stderr, "kernel_launch: unexpected shapes (n_in %d, out %d, ws %zu)\n", n_in, out_size, ws_size); grid = -1; return; }
        int dev = 0, cus = 0, per_cu = 0;
        if (hipGetDevice(&dev) != hipSuccess || hipDeviceGetAttribute(&cus, hipDeviceAttributeMultiprocessorCount, dev) != hipSuccess) { grid = -1; return; }
        if (hipFuncSetAttribute((const void*)hybrid_fwd, hipFuncAttributeMaxDynamicSharedMemorySize, LDS_BYTES) != hipSuccess) { fprintf(stderr, "kernel_launch: hipFuncSetAttribute failed\n"); grid = -1; return; }
        if (hipOccupancyMaxActiveBlocksPerMultiprocessor(&per_cu, (const void*)hybrid_fwd, 512, LDS_BYTES) != hipSuccess || per_cu < 1) { fprintf(stderr, "kernel_launch: occupancy query says %d blocks per CU\n", per_cu); (void)hipGetLastError(); per_cu = 1; }
        grid = cus * per_cu;
    }
    if (grid < 0) return;
    if (hipMemsetAsync((char*)d_ws + WS_BAR, 0, XCD_BAR_WORDS * 4, stream) != hipSuccess) { fprintf(stderr, "kernel_launch: memset of the barrier words failed\n"); return; }
    Args a{};
    for (int i = 0; i < 15; ++i) a.in[i] = (const float*)d_in[i];
    a.out = (float*)d_out; a.ws = (unsigned char*)d_ws;
#if MK_SPLIT
    for (int ph = 0; ph < NPHASE; ++ph) { a.ph_lo = ph; a.ph_hi = ph + 1; hipLaunchKernelGGL(hybrid_fwd, dim3(grid), dim3(512), LDS_BYTES, stream, a); }
#else
    a.ph_lo = 0; a.ph_hi = NPHASE;
    void* kargs[] = {&a};
    const hipError_t e = hipLaunchCooperativeKernel((const void*)hybrid_fwd, dim3(grid), dim3(512), kargs, LDS_BYTES, stream);
    if (e != hipSuccess) fprintf(stderr, "kernel_launch: cooperative launch failed: %s (grid %d)\n", hipGetErrorString(e), grid);
#endif
}
```

```cpp
#include <hip/hip_runtime.h>
#include <hip/hip_cooperative_groups.h>
#include <cstdio>
#include <cstdint>
namespace cg = cooperative_groups;
#ifndef MK_REPEAT
#define MK_REPEAT 0
#endif
namespace pg8 {
#define PG8_LAS __attribute__((address_space(3)))
typedef unsigned short bf16_t;
typedef short bf16x8 __attribute__((ext_vector_type(8)));
typedef float f32x4 __attribute__((ext_vector_type(4)));
typedef unsigned u32x4 __attribute__((ext_vector_type(4)));
constexpr int BM = 256, BK = 64, HALF = 128, HTB = HALF * BK * 2  , STAGE_BYTES = 8 * HTB, NXCD = 8, WGM = 8;

__host__ __device__ __forceinline__ int lds_byte(int r, int c) { const int st = (r >> 4) * 2 + (c >> 5), rr = r & 15, cc = c & 31, ob = rr * 64 + cc * 2; return st * 1024 + (ob ^ (((ob >> 9) & 1) << 5)); }
__host__ __device__ __forceinline__ void stage_rc(int b, int& R, int& C) { const int st = b / 1024, sb = b % 1024, swz = sb ^ (((sb >> 9) & 1) << 5); R = (st >> 1) * 16 + swz / 64; C = (st & 1) * 32 + (swz % 64) / 2; }
__host__ __device__ __forceinline__ int perm32(int rho) { const int n = rho >> 4, i = rho & 15; return 8 * (i >> 2) + 4 * n + (i & 3); }

struct Unit { int pm, pn; };
struct Gemm { const bf16_t* A; const bf16_t* Bt; int M, N, K; };

struct StaticOrder {
    int nM, nN, nwg, G, c;
    __host__ __device__ void init(int M, int N, int G_, int c_) { nM = M / BM; nN = N / BM; nwg = nM * nN; G = G_; c = c_; }
    __host__ __device__ bool next(int i, Unit& u) const {
        const long L = (long)i * G + c; if (L >= nwg) return false;
        int wgid = (int)L; { const int q = nwg / NXCD, r = nwg % NXCD, xcd = wgid % NXCD, off = wgid / NXCD; wgid = (xcd < r ? xcd * (q + 1) : r * (q + 1) + (xcd - r) * q) + off; }
        const int nig = WGM * nN, gid = wgid / nig, fm = gid * WGM, gsz = (nM - fm) < WGM ? (nM - fm) : WGM;
        u.pm = fm + ((wgid % nig) % gsz); u.pn = (wgid % nig) / gsz; return true;
    }
    __device__ __forceinline__ void a_ready(const Unit&) const {}
    __device__ __forceinline__ void done(const Unit&) const {}
};


typedef float f32x2_t __attribute__((ext_vector_type(2))); typedef __bf16 bf16x2_t __attribute__((ext_vector_type(2)));
__device__ __forceinline__ unsigned pk2(float lo, float hi) { f32x2_t v = {lo, hi}; bf16x2_t b = __builtin_convertvector(v, bf16x2_t); return __builtin_bit_cast(unsigned, b); }
__device__ __forceinline__ u32x4 pk8(const f32x4 a, const f32x4 b) { u32x4 w; w.x = pk2(a[0], a[1]); w.y = pk2(a[2], a[3]); w.z = pk2(b[0], b[1]); w.w = pk2(b[2], b[3]); return w; }

constexpr float QSCALE = 0.18033688011112042f;
constexpr float NORM_EPS = 1e-6f;
constexpr int PROJ_LD = 3072;

#define EPI_FENCE() asm volatile("" ::: "memory")

struct EpiInProj {
    static constexpr bool PERM = true, AFTER_DRAIN = false;
    bf16_t* P; const float* qw; const float* kw; const float* rc; const float* rs;
    __device__ __forceinline__ void operator()(const f32x4 (&acc)[2][2][4][2], const Unit& u, int wr, int wc, int fr, int fq) const {
        const int row0 = u.pm * BM + wr * 64 + fr, cbase = u.pn * BM + 64 * wc + 8 * fq;
        if (u.pn < 4) {
            const bool isq = u.pn < 2; const float* w = isq ? qw : kw; const float osc = isq ? QSCALE : 1.0f;
            f32x4 wv[2][2];
#pragma unroll
            for (int bj = 0; bj < 2; ++bj)
#pragma unroll
                for (int n = 0; n < 2; ++n) wv[bj][n] = *(const f32x4*)(w + 32 * bj + 8 * fq + 4 * n);
            f32x4 tc[2][2], ts[2][2];
#pragma unroll
            for (int g = 0; g < 2; ++g) { const int t = (row0 + g * 16) & 2047;
#pragma unroll
                for (int n = 0; n < 2; ++n) { tc[g][n] = *(const f32x4*)(rc + t * 32 + 8 * fq + 4 * n); ts[g][n] = *(const f32x4*)(rs + t * 32 + 8 * fq + 4 * n); } }
            EPI_FENCE();
#pragma unroll
            for (int g = 0; g < 8; ++g) {
                const int ai = g >> 2, m = g & 3, row = row0 + ai * HALF + m * 16;
                float ss = 0.f;
#pragma unroll
                for (int bj = 0; bj < 2; ++bj)
#pragma unroll
                    for (int n = 0; n < 2; ++n) { const f32x4 v = acc[ai][bj][m][n]; ss += (v[0] * v[0] + v[1] * v[1]) + (v[2] * v[2] + v[3] * v[3]); }
                ss += __shfl_xor(ss, 16); ss += __shfl_xor(ss, 32);
                const float rstd = rsqrtf(ss * (1.0f / 64.0f) + NORM_EPS);
                f32x4 o1[2], o2[2];
#pragma unroll
                for (int n = 0; n < 2; ++n) {
                    const f32x4 cs = tc[g & 1][n], sn = ts[g & 1][n];
                    const f32x4 x1 = acc[ai][0][m][n] * rstd * wv[0][n], x2 = acc[ai][1][m][n] * rstd * wv[1][n];
                    o1[n] = (x1 * cs - x2 * sn) * osc; o2[n] = (x2 * cs + x1 * sn) * osc;
                }
                bf16_t* rp = P + (size_t)row * PROJ_LD + cbase;
                *(u32x4*)(rp) = pk8(o1[0], o1[1]); *(u32x4*)(rp + 32) = pk8(o2[0], o2[1]);
                if (g + 2 < 8) { const int g2 = g + 2; const int t = (row0 + (g2 >> 2) * HALF + (g2 & 3) * 16) & 2047;
#pragma unroll
                    for (int n = 0; n < 2; ++n) { tc[g & 1][n] = *(const f32x4*)(rc + t * 32 + 8 * fq + 4 * n); ts[g & 1][n] = *(const f32x4*)(rs + t * 32 + 8 * fq + 4 * n); } }
                EPI_FENCE();
            }
        } else {
#pragma unroll
            for (int ai = 0; ai < 2; ++ai)
#pragma unroll
                for (int m = 0; m < 4; ++m) { bf16_t* rp = P + (size_t)(row0 + ai * HALF + m * 16) * PROJ_LD + cbase;
#pragma unroll
                    for (int bj = 0; bj < 2; ++bj) *(u32x4*)(rp + 32 * bj) = pk8(acc[ai][bj][m][0], acc[ai][bj][m][1]); }
        }
    }
};

struct EpiOutProj {
    static constexpr bool PERM = true, AFTER_DRAIN = false;
    const float* x; bf16_t* x1b; float* part;
    __device__ __forceinline__ void operator()(const f32x4 (&acc)[2][2][4][2], const Unit& u, int wr, int wc, int fr, int fq) const {
        const int row0 = u.pm * BM + wr * 64 + fr, c0 = u.pn * BM + wc * 32 + 8 * fq;
        f32x4 pre[4][2][2];
#pragma unroll
        for (int g = 0; g < 4; ++g) { const float* xp = x + (size_t)(row0 + g * 16) * 1024 + c0;
#pragma unroll
            for (int bj = 0; bj < 2; ++bj) { pre[g][bj][0] = *(const f32x4*)(xp + bj * HALF); pre[g][bj][1] = *(const f32x4*)(xp + bj * HALF + 4); } }
        EPI_FENCE();
#pragma unroll
        for (int g = 0; g < 8; ++g) {
            const int ai = g >> 2, m = g & 3, row = row0 + ai * HALF + m * 16; const size_t off = (size_t)row * 1024 + c0; float ss = 0.f;
#pragma unroll
            for (int bj = 0; bj < 2; ++bj) {
                const f32x4 a = acc[ai][bj][m][0] + pre[m][bj][0], b = acc[ai][bj][m][1] + pre[m][bj][1];
                *(u32x4*)(x1b + off + bj * HALF) = pk8(a, b);
                ss += (a[0] * a[0] + a[1] * a[1]) + (a[2] * a[2] + a[3] * a[3]) + (b[0] * b[0] + b[1] * b[1]) + (b[2] * b[2] + b[3] * b[3]);
            }
            if (g + 4 < 8) { const float* xp = x + (size_t)(row0 + HALF + m * 16) * 1024 + c0;
#pragma unroll
                for (int bj = 0; bj < 2; ++bj) { pre[m][bj][0] = *(const f32x4*)(xp + bj * HALF); pre[m][bj][1] = *(const f32x4*)(xp + bj * HALF + 4); } }
            ss += __shfl_xor(ss, 16); ss += __shfl_xor(ss, 32);
            if (fq == 0) part[(size_t)row * 16 + u.pn * 4 + wc] = ss;
            EPI_FENCE();
        }
    }
};

struct EpiUp {
    static constexpr bool PERM = true, AFTER_DRAIN = false;
    bf16_t* act; const float* part;
    __device__ __forceinline__ void operator()(const f32x4 (&acc)[2][2][4][2], const Unit& u, int wr, int wc, int fr, int fq) const {
        const int row0 = u.pm * BM + wr * 64 + fr, c0 = u.pn * BM + wc * 32 + 8 * fq;
        f32x4 pp[8];
#pragma unroll
        for (int g = 0; g < 8; ++g) pp[g] = *(const f32x4*)(part + (size_t)(row0 + (g >> 2) * HALF + (g & 3) * 16) * 16 + 4 * fq);
        EPI_FENCE();
        float rstd[8];
#pragma unroll
        for (int g = 0; g < 8; ++g) { float s = (pp[g][0] + pp[g][1]) + (pp[g][2] + pp[g][3]); s += __shfl_xor(s, 16); s += __shfl_xor(s, 32); rstd[g] = rsqrtf(s * (1.0f / 1024.0f) + NORM_EPS); }
#pragma unroll
        for (int g = 0; g < 8; ++g) {
            const int ai = g >> 2, m = g & 3; bf16_t* rp = act + (size_t)(row0 + ai * HALF + m * 16) * 4096 + c0;
#pragma unroll
            for (int bj = 0; bj < 2; ++bj) {
                f32x4 a = acc[ai][bj][m][0] * rstd[g], b = acc[ai][bj][m][1] * rstd[g];
#pragma unroll
                for (int e = 0; e < 4; ++e) { a[e] = a[e] > 0.f ? a[e] * a[e] : 0.f; b[e] = b[e] > 0.f ? b[e] * b[e] : 0.f; }
                *(u32x4*)(rp + bj * HALF) = pk8(a, b);
            }
        }
    }
};

struct EpiDown {
    static constexpr bool PERM = true, AFTER_DRAIN = false;
    float* out; const bf16_t* x1b;
    __device__ __forceinline__ void operator()(const f32x4 (&acc)[2][2][4][2], const Unit& u, int wr, int wc, int fr, int fq) const {
        const int row0 = u.pm * BM + wr * 64 + fr, c0 = u.pn * BM + wc * 32 + 8 * fq;
        u32x4 pre[8][2];
#pragma unroll
        for (int g = 0; g < 8; ++g) { const bf16_t* xp = x1b + (size_t)(row0 + (g >> 2) * HALF + (g & 3) * 16) * 1024 + c0; pre[g][0] = *(const u32x4*)xp; pre[g][1] = *(const u32x4*)(xp + HALF); }
        EPI_FENCE();
#pragma unroll
        for (int g = 0; g < 8; ++g) {
            const int ai = g >> 2, m = g & 3; const size_t off = (size_t)(row0 + ai * HALF + m * 16) * 1024 + c0;
#pragma unroll
            for (int bj = 0; bj < 2; ++bj) { const u32x4 r = pre[g][bj];
                f32x4 a, b; a[0] = __uint_as_float(r.x << 16); a[1] = __uint_as_float(r.x & 0xffff0000u); a[2] = __uint_as_float(r.y << 16); a[3] = __uint_as_float(r.y & 0xffff0000u);
                b[0] = __uint_as_float(r.z << 16); b[1] = __uint_as_float(r.z & 0xffff0000u); b[2] = __uint_as_float(r.w << 16); b[3] = __uint_as_float(r.w & 0xffff0000u);
                *(f32x4*)(out + off + bj * HALF) = a + acc[ai][bj][m][0]; *(f32x4*)(out + off + bj * HALF + 4) = b + acc[ai][bj][m][1]; }
        }
    }
};


struct EpiUpT {
    static constexpr bool PERM = true, AFTER_DRAIN = false;
    bf16_t* act; const float* part; const PG8_LAS float* rt; int pmc;
    __device__ __forceinline__ void operator()(const f32x4 (&acc)[2][2][4][2], const Unit& u, int wr, int wc, int fr, int fq) const {
        const int row0 = u.pm * BM + wr * 64 + fr, c0 = u.pn * BM + wc * 32 + 8 * fq;
        float rstd[8];
        if (u.pm == pmc) {
#pragma unroll
            for (int g = 0; g < 8; ++g) rstd[g] = rt[(g >> 2) * HALF + wr * 64 + (g & 3) * 16 + fr];
        } else {
            f32x4 pp[8];
#pragma unroll
            for (int g = 0; g < 8; ++g) pp[g] = *(const f32x4*)(part + (size_t)(row0 + (g >> 2) * HALF + (g & 3) * 16) * 16 + 4 * fq);
            EPI_FENCE();
#pragma unroll
            for (int g = 0; g < 8; ++g) { float s = (pp[g][0] + pp[g][1]) + (pp[g][2] + pp[g][3]); s += __shfl_xor(s, 16); s += __shfl_xor(s, 32); rstd[g] = rsqrtf(s * (1.0f / 1024.0f) + NORM_EPS); }
        }
#pragma unroll
        for (int g = 0; g < 8; ++g) {
            const int ai = g >> 2, m = g & 3; bf16_t* rp = act + (size_t)(row0 + ai * HALF + m * 16) * 4096 + c0;
#pragma unroll
            for (int bj = 0; bj < 2; ++bj) {
                f32x4 a = acc[ai][bj][m][0] * rstd[g], b = acc[ai][bj][m][1] * rstd[g];
#pragma unroll
                for (int e = 0; e < 4; ++e) { a[e] = a[e] > 0.f ? a[e] * a[e] : 0.f; b[e] = b[e] > 0.f ? b[e] * b[e] : 0.f; }
                *(u32x4*)(rp + bj * HALF) = pk8(a, b);
            }
        }
    }
};

__device__ __forceinline__ void preload_f32_tile(f32x4 (&acc)[2][2][4][2], const float* x, const Unit& u, int wr, int wc, int fr, int fq) {
    const int row0 = u.pm * BM + wr * 64 + fr, c0 = u.pn * BM + wc * 32 + 8 * fq;
#pragma unroll
    for (int ai = 0; ai < 2; ++ai)
#pragma unroll
        for (int m = 0; m < 4; ++m) { const float* xp = x + (size_t)(row0 + ai * HALF + m * 16) * 1024 + c0;
#pragma unroll
            for (int bj = 0; bj < 2; ++bj) { acc[ai][bj][m][0] = *(const f32x4*)(xp + bj * HALF); acc[ai][bj][m][1] = *(const f32x4*)(xp + bj * HALF + 4); } }
}
__device__ __forceinline__ void preload_bf16_tile(f32x4 (&acc)[2][2][4][2], const bf16_t* xb, const Unit& u, int wr, int wc, int fr, int fq) {
    const int row0 = u.pm * BM + wr * 64 + fr, c0 = u.pn * BM + wc * 32 + 8 * fq;
#pragma unroll
    for (int ai = 0; ai < 2; ++ai)
#pragma unroll
        for (int m = 0; m < 4; ++m) { const bf16_t* xp = xb + (size_t)(row0 + ai * HALF + m * 16) * 1024 + c0;
#pragma unroll
            for (int bj = 0; bj < 2; ++bj) { const u32x4 r = *(const u32x4*)(xp + bj * HALF);
                acc[ai][bj][m][0] = (f32x4){__uint_as_float(r.x << 16), __uint_as_float(r.x & 0xffff0000u), __uint_as_float(r.y << 16), __uint_as_float(r.y & 0xffff0000u)};
                acc[ai][bj][m][1] = (f32x4){__uint_as_float(r.z << 16), __uint_as_float(r.z & 0xffff0000u), __uint_as_float(r.w << 16), __uint_as_float(r.w & 0xffff0000u)}; } }
}

__device__ __forceinline__ void preload_h_tile(f32x4 (&acc)[2][2][4][2], const bf16_t* H, const float* RS, const float* w, const Unit& u, int wr, int wc, int fr, int fq) {
    const int row0 = u.pm * BM + wr * 64 + fr, c0 = u.pn * BM + wc * 32 + 8 * fq;
    u32x4 raw[8][2]; float rs[8];
#pragma unroll
    for (int g = 0; g < 8; ++g) { const int row = row0 + (g >> 2) * HALF + (g & 3) * 16; const bf16_t* hp = H + (size_t)row * 1024 + c0;
        raw[g][0] = *(const u32x4*)hp; raw[g][1] = *(const u32x4*)(hp + HALF); rs[g] = RS[row]; }
    f32x4 iw[2][2];
#pragma unroll
    for (int bj = 0; bj < 2; ++bj)
#pragma unroll
        for (int n = 0; n < 2; ++n) { const f32x4 wv = *(const f32x4*)(w + c0 + bj * HALF + 4 * n); iw[bj][n] = (f32x4){1.0f / wv[0], 1.0f / wv[1], 1.0f / wv[2], 1.0f / wv[3]}; }
#pragma unroll
    for (int g = 0; g < 8; ++g) { const int ai = g >> 2, m = g & 3; const float ir = 1.0f / rs[g];
#pragma unroll
        for (int bj = 0; bj < 2; ++bj) { const u32x4 r = raw[g][bj];
            acc[ai][bj][m][0] = (f32x4){__uint_as_float(r.x << 16), __uint_as_float(r.x & 0xffff0000u), __uint_as_float(r.y << 16), __uint_as_float(r.y & 0xffff0000u)} * ir * iw[bj][0];
            acc[ai][bj][m][1] = (f32x4){__uint_as_float(r.z << 16), __uint_as_float(r.z & 0xffff0000u), __uint_as_float(r.w << 16), __uint_as_float(r.w & 0xffff0000u)} * ir * iw[bj][1]; } }
}
struct EpiOutProjPre {
    static constexpr bool PERM = true, AFTER_DRAIN = false;
    bf16_t* x1b; float* part;
    __device__ __forceinline__ void operator()(const f32x4 (&acc)[2][2][4][2], const Unit& u, int wr, int wc, int fr, int fq) const {
        const int row0 = u.pm * BM + wr * 64 + fr, c0 = u.pn * BM + wc * 32 + 8 * fq;
#pragma unroll
        for (int g = 0; g < 8; ++g) {
            const int ai = g >> 2, m = g & 3, row = row0 + ai * HALF + m * 16; const size_t off = (size_t)row * 1024 + c0; float ss = 0.f;
#pragma unroll
            for (int bj = 0; bj < 2; ++bj) { const f32x4 a = acc[ai][bj][m][0], b = acc[ai][bj][m][1];
                *(u32x4*)(x1b + off + bj * HALF) = pk8(a, b);
                ss += (a[0] * a[0] + a[1] * a[1]) + (a[2] * a[2] + a[3] * a[3]) + (b[0] * b[0] + b[1] * b[1]) + (b[2] * b[2] + b[3] * b[3]); }
            ss += __shfl_xor(ss, 16); ss += __shfl_xor(ss, 32);
            if (fq == 0) part[(size_t)row * 16 + u.pn * 4 + wc] = ss;
        }
    }
};
struct EpiDownPre {
    static constexpr bool PERM = true, AFTER_DRAIN = false;
    float* out;
    __device__ __forceinline__ void operator()(const f32x4 (&acc)[2][2][4][2], const Unit& u, int wr, int wc, int fr, int fq) const {
        const int row0 = u.pm * BM + wr * 64 + fr, c0 = u.pn * BM + wc * 32 + 8 * fq;
#pragma unroll
        for (int ai = 0; ai < 2; ++ai)
#pragma unroll
            for (int m = 0; m < 4; ++m) { float* rp = out + (size_t)(row0 + ai * HALF + m * 16) * 1024 + c0;
#pragma unroll
                for (int bj = 0; bj < 2; ++bj) { *(f32x4*)(rp + bj * HALF) = acc[ai][bj][m][0]; *(f32x4*)(rp + bj * HALF + 4) = acc[ai][bj][m][1]; } }
    }
};

template <class Epi, class Sched, bool ALIGN_EPI = false, bool SP2 = false, bool PRELOADED = false>
__device__ __forceinline__ void gemm_phase(PG8_LAS unsigned char* lds, const Gemm g, const Sched& S, const Epi& E, f32x4 (&acc)[2][2][4][2]) {
    const int tid = threadIdx.x, wid = __builtin_amdgcn_readfirstlane(tid >> 6), lane = tid & 63, wr = wid >> 2, wc = wid & 3, fr = lane & 15, fq = lane >> 4;
    const int K = g.K, nt = K / BK;
    unsigned voffA[2], voffB[2];
#pragma unroll
    for (int i = 0; i < 2; ++i) { int R, C; stage_rc(tid * 16 + i * 8192, R, C); const int Rb = Epi::PERM ? ((R & ~31) + perm32(R & 31)) : R;
        voffA[i] = (unsigned)(R * K + C) * 2u; voffB[i] = (unsigned)(Rb * K + C) * 2u; }
    const size_t kstep = (size_t)(BK * 2);
    const size_t hstep = (size_t)HALF * K * 2;
    const size_t tstep = 2 * hstep;
    const unsigned ldsw = (unsigned)wid * 1024u;
    const int aoff = lds_byte(wr * 64 + fr, fq * 8), boff = lds_byte(wc * 32 + fr, fq * 8);
#define PG8_SA(b, h) (((b) * 2 + (h)) * HTB)
#define PG8_SB(b, h) ((4 + (b) * 2 + (h)) * HTB)
#define PG8_STAGE(bufoff, gbase, voff) do { _Pragma("unroll") for (int _i = 0; _i < 2; ++_i) \
        __builtin_amdgcn_global_load_lds((const unsigned*)((const char*)(gbase) + (voff)[_i]), (PG8_LAS unsigned*)(lds + (bufoff) + ldsw + _i * 8192), 16, 0, 0); } while (0)
#define PG8_LDA(dst, b, h) do { _Pragma("unroll") for (int m = 0; m < 4; ++m) _Pragma("unroll") for (int k = 0; k < 2; ++k) dst[m][k] = *(const PG8_LAS bf16x8*)(lds + PG8_SA(b, h) + aoff + m * 2048 + k * 1024); } while (0)
#define PG8_LDB(dst, b, h) do { _Pragma("unroll") for (int n = 0; n < 2; ++n) _Pragma("unroll") for (int k = 0; k < 2; ++k) dst[n][k] = *(const PG8_LAS bf16x8*)(lds + PG8_SB(b, h) + boff + n * 2048 + k * 1024); } while (0)
#define PG8_MMA(ai, bj, At, Bt) do { __builtin_amdgcn_s_setprio(1); _Pragma("unroll") for (int m = 0; m < 4; ++m) _Pragma("unroll") for (int n = 0; n < 2; ++n) _Pragma("unroll") for (int k = 0; k < 2; ++k) \
        acc[ai][bj][m][n] = __builtin_amdgcn_mfma_f32_16x16x32_bf16(Bt[n][k], At[m][k], acc[ai][bj][m][n], 0, 0, 0); __builtin_amdgcn_s_setprio(0); } while (0)
#define PG8_WAIT_V(n) asm volatile("s_waitcnt vmcnt(" #n ")" ::: "memory")
#define PG8_WAIT_L(n) asm volatile("s_waitcnt lgkmcnt(" #n ")" ::: "memory")
#define PG8_BAR __builtin_amdgcn_s_barrier()
#define PG8_SCHED __builtin_amdgcn_sched_barrier(0)
    Unit cur, nxt; int ui = 0;
    if (!S.next(0, cur)) return;
    if constexpr (!PRELOADED) {
#pragma unroll
    for (int a = 0; a < 2; ++a)
#pragma unroll
        for (int b = 0; b < 2; ++b)
#pragma unroll
            for (int m = 0; m < 4; ++m)
#pragma unroll
                for (int n = 0; n < 2; ++n) acc[a][b][m][n] = (f32x4){0.f, 0.f, 0.f, 0.f};
    }
    bf16x8 At[4][2], B0[2][2], B1[2][2];
    const char* cA = (const char*)g.A + (size_t)cur.pm * tstep; const char* cB = (const char*)g.Bt + (size_t)cur.pn * tstep;
    S.a_ready(cur);
    if constexpr (SP2) {
        PG8_STAGE(PG8_SB(0, 0), cB, voffB); PG8_STAGE(PG8_SB(0, 1), cB + hstep, voffB); PG8_STAGE(PG8_SA(0, 0), cA, voffA); PG8_STAGE(PG8_SA(0, 1), cA + hstep, voffA);
        if (wr == 1) PG8_BAR;
        PG8_WAIT_V(2); PG8_BAR;
        PG8_STAGE(PG8_SB(1, 0), cB + kstep, voffB); PG8_STAGE(PG8_SA(1, 0), cA + kstep, voffA); PG8_STAGE(PG8_SB(1, 1), cB + hstep + kstep, voffB);
        PG8_WAIT_V(6); PG8_BAR;
    } else {
        PG8_STAGE(PG8_SB(0, 0), cB, voffB); PG8_STAGE(PG8_SA(0, 0), cA, voffA); PG8_STAGE(PG8_SB(0, 1), cB + hstep, voffB); PG8_STAGE(PG8_SA(0, 1), cA + hstep, voffA);
        if (wr == 1) PG8_BAR;
        PG8_WAIT_V(4); PG8_BAR;
        PG8_STAGE(PG8_SB(1, 0), cB + kstep, voffB); PG8_STAGE(PG8_SA(1, 0), cA + kstep, voffA); PG8_STAGE(PG8_SB(1, 1), cB + hstep + kstep, voffB);
        PG8_WAIT_V(6); PG8_BAR;
    }
    for (;;) {
        const bool has_next = S.next(ui + 1, nxt);
        const char* nA = has_next ? (const char*)g.A + (size_t)nxt.pm * tstep : cA; const char* nB = has_next ? (const char*)g.Bt + (size_t)nxt.pn * tstep : cB;
        for (int t = 0; t < nt; t += 2) {
            const bool last = (t == nt - 2);
            const char* a1 = cA + (size_t)(t + 1) * kstep;
            const char* a2 = last ? nA : cA + (size_t)(t + 2) * kstep; const char* b2 = last ? nB : cB + (size_t)(t + 2) * kstep;
            const char* a3 = a2 + kstep; const char* b3 = b2 + kstep;
            if (last && has_next) S.a_ready(nxt);
            if constexpr (SP2) {
            PG8_LDB(B0, 0, 0); PG8_LDB(B1, 0, 1); PG8_SCHED; PG8_LDA(At, 0, 0); PG8_STAGE(PG8_SA(1, 1), a1 + hstep, voffA);
            PG8_WAIT_V(8); PG8_WAIT_L(0); PG8_BAR; PG8_MMA(0, 0, At, B0); PG8_MMA(0, 1, At, B1); PG8_BAR; PG8_SCHED;
            PG8_LDA(At, 0, 1); PG8_STAGE(PG8_SB(0, 0), b2, voffB); PG8_STAGE(PG8_SB(0, 1), b2 + hstep, voffB); PG8_STAGE(PG8_SA(0, 0), a2, voffA);
            PG8_WAIT_V(8); PG8_WAIT_L(0); PG8_BAR; PG8_MMA(1, 0, At, B0); PG8_MMA(1, 1, At, B1); PG8_BAR; PG8_SCHED;
            PG8_LDB(B0, 1, 0); PG8_LDB(B1, 1, 1); PG8_SCHED; PG8_LDA(At, 1, 0); PG8_STAGE(PG8_SA(0, 1), a2 + hstep, voffA);
            PG8_WAIT_V(8); PG8_WAIT_L(0); PG8_BAR; PG8_MMA(0, 0, At, B0); PG8_MMA(0, 1, At, B1); PG8_BAR; PG8_SCHED;
            PG8_LDA(At, 1, 1); PG8_STAGE(PG8_SB(1, 0), b3, voffB); PG8_STAGE(PG8_SB(1, 1), b3 + hstep, voffB); PG8_STAGE(PG8_SA(1, 0), a3, voffA);
            PG8_WAIT_V(8); PG8_WAIT_L(0); PG8_BAR; PG8_MMA(1, 0, At, B0); PG8_MMA(1, 1, At, B1); PG8_BAR; PG8_SCHED;
            } else {
            PG8_LDB(B0, 0, 0); PG8_SCHED; PG8_LDA(At, 0, 0); PG8_STAGE(PG8_SA(1, 1), a1 + hstep, voffA);
            PG8_WAIT_L(8); PG8_BAR; PG8_WAIT_L(0); PG8_MMA(0, 0, At, B0); PG8_BAR; PG8_SCHED;
            PG8_LDB(B1, 0, 1); PG8_STAGE(PG8_SB(0, 0), b2, voffB);
            PG8_BAR; PG8_WAIT_L(0); PG8_MMA(0, 1, At, B1); PG8_BAR;
            PG8_LDA(At, 0, 1); PG8_STAGE(PG8_SA(0, 0), a2, voffA);
            PG8_BAR; PG8_WAIT_L(0); PG8_MMA(1, 0, At, B0); PG8_BAR; PG8_SCHED;
            PG8_STAGE(PG8_SB(0, 1), b2 + hstep, voffB);
            PG8_WAIT_V(6); PG8_BAR; PG8_MMA(1, 1, At, B1); PG8_BAR;
            PG8_LDB(B0, 1, 0); PG8_SCHED; PG8_LDA(At, 1, 0); PG8_STAGE(PG8_SA(0, 1), a2 + hstep, voffA);
            PG8_WAIT_L(8); PG8_BAR; PG8_WAIT_L(0); PG8_MMA(0, 0, At, B0); PG8_BAR; PG8_SCHED;
            PG8_LDB(B1, 1, 1); PG8_STAGE(PG8_SB(1, 0), b3, voffB);
            PG8_BAR; PG8_WAIT_L(0); PG8_MMA(0, 1, At, B1); PG8_BAR;
            PG8_LDA(At, 1, 1); PG8_STAGE(PG8_SA(1, 0), a3, voffA);
            PG8_BAR; PG8_WAIT_L(0); PG8_MMA(1, 0, At, B0); PG8_BAR; PG8_SCHED;
            PG8_STAGE(PG8_SB(1, 1), b3 + hstep, voffB);
            PG8_WAIT_V(6); PG8_BAR; PG8_MMA(1, 1, At, B1); PG8_BAR;
            }
        }
        if constexpr (ALIGN_EPI) { if (wr == 0) PG8_BAR; }
        if constexpr (!Epi::AFTER_DRAIN) { E(acc, cur, wr, wc, fr, fq); S.done(cur); }
        if (!has_next) break;
#pragma unroll
        for (int a = 0; a < 2; ++a)
#pragma unroll
            for (int b = 0; b < 2; ++b)
#pragma unroll
                for (int m = 0; m < 4; ++m)
#pragma unroll
                    for (int n = 0; n < 2; ++n) acc[a][b][m][n] = (f32x4){0.f, 0.f, 0.f, 0.f};
        cur = nxt; cA = nA; cB = nB; ++ui;
        if constexpr (ALIGN_EPI) { if (wr == 1) PG8_BAR; }
    }
    PG8_WAIT_V(0);
    if constexpr (!ALIGN_EPI) { if (wr == 0) PG8_BAR; }
    PG8_BAR;
    if constexpr (Epi::AFTER_DRAIN) { E.fused(acc, cur, wr, wc, fr, fq, lds, wid, lane); S.done(cur); }
#undef PG8_SA
#undef PG8_SB
#undef PG8_STAGE
#undef PG8_LDA
#undef PG8_LDB
#undef PG8_MMA
#undef PG8_WAIT_V
#undef PG8_WAIT_L
#undef PG8_BAR
#undef PG8_SCHED
}
}

#define LAS __attribute__((address_space(3)))
typedef unsigned short bf16_t;
typedef short bf16x8 __attribute__((ext_vector_type(8)));
typedef short s16x4 __attribute__((ext_vector_type(4)));
typedef float f32x4 __attribute__((ext_vector_type(4)));
typedef float f32x16 __attribute__((ext_vector_type(16)));
typedef unsigned u32x4 __attribute__((ext_vector_type(4)));
typedef unsigned u32x2 __attribute__((ext_vector_type(2)));
using pg8::pk2;

constexpr int M = 16384, D = 1024, SEQ = 2048, FF = 4096, NPROJ = 3072, INW = 3080;
constexpr size_t MiB = 1u << 20;
constexpr size_t WS_WIN = 0, WS_WOUT = 6 * MiB, WS_WUP = 8 * MiB, WS_WDOWN = 16 * MiB, WS_ROPE = 24 * MiB, WS_DT = WS_ROPE + 512 * 1024, WS_ACS = 25 * MiB,
                 WS_PART = WS_ACS + 512 * 1024, WS_LP = WS_PART + MiB, WS_MIX = 28 * MiB, WS_CS = 60 * MiB, WS_X1B = 60 * MiB, WS_SIN = 92 * MiB,
                 WS_BIG = 108 * MiB, WS_H = WS_BIG, WS_XBCC = WS_BIG, WS_PROJ = WS_BIG + 32 * MiB, WS_ACT = WS_BIG, WS_CC = 236 * MiB  , WS_RS = 244 * MiB  , WS_BAR = 245 * MiB  , WS_END = 246 * MiB;
constexpr int LDS_BYTES = 143360;
constexpr int NPHASE = 8;
#ifndef MK_SPLIT
#define MK_SPLIT 0
#endif

#define REP(k) for (int rep_ = 0; rep_ < 1 + ((MK_REPEAT >> (k)) & 1); ++rep_)
#define LDS_WAIT() asm volatile("s_waitcnt lgkmcnt(0)" ::: "memory")
#define LDS_BARRIER() do { asm volatile("s_waitcnt lgkmcnt(0)" ::: "memory"); __builtin_amdgcn_s_barrier(); asm volatile("" ::: "memory"); } while (0)
__device__ __forceinline__ float bflo(unsigned w) { return __uint_as_float(w << 16); }
__device__ __forceinline__ float bfhi(unsigned w) { return __uint_as_float(w & 0xffff0000u); }
__device__ __forceinline__ float wave_sum(float v) {
#pragma unroll
    for (int o = 1; o < 64; o <<= 1) v += __shfl_xor(v, o);
    return v;
}
__device__ __forceinline__ f32x16 mfma32(bf16x8 a, bf16x8 b, f32x16 c) { return __builtin_amdgcn_mfma_f32_32x32x16_bf16(a, b, c, 0, 0, 0); }
__device__ __forceinline__ s16x4 trd(const LAS unsigned char* p) { return __builtin_bit_cast(s16x4, __builtin_amdgcn_ds_read_tr16_b64_v4i16((LAS s16x4*)p)); }
__device__ __forceinline__ bf16x8 cat8(s16x4 lo, s16x4 hi) { return (bf16x8){lo[0], lo[1], lo[2], lo[3], hi[0], hi[1], hi[2], hi[3]}; }
__device__ __forceinline__ float silu_f(float v) { return v / (1.0f + __expf(-v)); }

#define XB_TMO      128
#define XB_XCNT(j)  (256  + 64 * (j))
#define XB_XSUB(j)  (1280 + 64 * (j))
#define XB_XGEN(j)  (2304 + 64 * (j))
#define XB_TOP      3328
#define XB_TOPGEN   3392
#define XCD_BAR_WORDS 3456
#define XB_SPIN_CAP (1u << 18)

__device__ __forceinline__ unsigned xb_ld(unsigned* p)              { return __hip_atomic_load(p, __ATOMIC_RELAXED, __HIP_MEMORY_SCOPE_AGENT); }
__device__ __forceinline__ unsigned xb_add(unsigned* p, unsigned v) { return __hip_atomic_fetch_add(p, v, __ATOMIC_RELAXED, __HIP_MEMORY_SCOPE_AGENT); }
__device__ __forceinline__ unsigned xb_xcc_id() { return (unsigned)__builtin_amdgcn_s_getreg((3 << 11) | 20) & 0xFu; }
#define XB_SPIN(cond, bar) do { unsigned _sp = 0; while (cond) { __builtin_amdgcn_s_sleep(1); \
    if ((++_sp & 255u) == 0u) { if (xb_ld(&(bar)[XB_TMO])) break; if (_sp > XB_SPIN_CAP) { atomicAdd(&(bar)[XB_TMO], 1u); break; } } } } while (0)

struct XcdBarrier {
    unsigned* bar; unsigned x;
    volatile LAS unsigned* st;
};

__device__ __forceinline__ XcdBarrier xcd_barrier_post(unsigned* bar, volatile LAS unsigned* st) {
    XcdBarrier b; b.bar = bar; b.x = xb_xcc_id(); b.st = st;
    if (threadIdx.x == 0) (void)xb_add(&bar[XB_XCNT(b.x)], 1u);
    return b;
}
__device__ __forceinline__ void xcd_barrier_complete(unsigned* bar, unsigned x, unsigned& nloc, unsigned& nx) {
    const unsigned G = gridDim.x * gridDim.y * gridDim.z;
    unsigned sum, cnt, mine, sp = 0u;
    for (;;) {
        sum = 0u; cnt = 0u; mine = 0u;
#pragma unroll
        for (unsigned j = 0; j < 16; ++j) { const unsigned c = xb_ld(&bar[XB_XCNT(j)]); sum += c; cnt += (c > 0u) ? 1u : 0u; mine = (j == x) ? c : mine; }
        if (sum == G) break;
        __builtin_amdgcn_s_sleep(1);
        if ((++sp & 255u) == 0u) { if (xb_ld(&bar[XB_TMO])) break; if (sp > XB_SPIN_CAP) { atomicAdd(&bar[XB_TMO], 1u); break; } }
    }
    nloc = mine > 0u ? mine : 1u; nx = cnt > 0u ? cnt : 1u;
}

__device__ __forceinline__ void xcd_barrier_leader(const XcdBarrier& b) {
        unsigned* bar = b.bar;
        __builtin_amdgcn_s_setprio(3);
        __builtin_amdgcn_s_waitcnt(0);
        unsigned nloc = b.st[0], nx = b.st[1];
        if (nloc == 0u) { xcd_barrier_complete(bar, b.x, nloc, nx); b.st[0] = nloc; b.st[1] = nx; }
        const unsigned old = xb_add(&bar[XB_XSUB(b.x)], 1u);
        const unsigned gen = old / nloc;
        if (old + 1u == (gen + 1u) * nloc) {
            __builtin_amdgcn_fence(__ATOMIC_RELEASE, "agent");
            asm volatile("s_waitcnt vmcnt(0)" ::: "memory");
            const unsigned og = xb_add(&bar[XB_TOP], 1u);
            const unsigned tg = og / nx;
            if (og + 1u == (tg + 1u) * nx) xb_add(&bar[XB_TOPGEN], 1u);
            else XB_SPIN(xb_ld(&bar[XB_TOPGEN]) == tg, bar);
            __builtin_amdgcn_fence(__ATOMIC_ACQUIRE, "agent");
            asm volatile("s_waitcnt vmcnt(0)" ::: "memory");
        } else {
            XB_SPIN(xb_ld(&bar[XB_TOPGEN]) == gen, bar);
            __builtin_amdgcn_fence(__ATOMIC_ACQUIRE, "agent");
            asm volatile("s_waitcnt vmcnt(0)" ::: "memory");
        }
        __builtin_amdgcn_s_setprio(0);
}
__device__ __forceinline__ void xcd_barrier(const XcdBarrier& b) {
    asm volatile("s_waitcnt vmcnt(0)" ::: "memory");
    __syncthreads();
    if (threadIdx.x == 0) xcd_barrier_leader(b);
    __syncthreads();
}


struct Ctx {
    const float *x, *attn_norm_w, *w_in, *q_norm_w, *k_norm_w, *conv_w, *conv_b, *dt_bias, *a_log, *d_skip, *ssd_norm_w, *w_out, *mlp_norm_w, *w_up, *w_down;
    float* out; unsigned char* ws;
    bf16_t *Win, *Wout, *Wup, *Wdown, *H, *XBCC, *PROJ, *ACT, *MIX, *X1B, *SIN, *OP;
    float *ROPEC, *ROPES, *DT, *ACS, *PART, *LP, *RS; bf16_t *CS, *CC;
    LAS unsigned char* lds; int tid, lane, wave, G;
};

__device__ __forceinline__ void p0_transpose_tile(const Ctx& F, const float* W, int ldn, int K, bf16_t* WT, int k0, int n0, int ncols, bool perm, const float* kscale) {
    LAS float* tile = (LAS float*)F.lds;
    f32x4 tv[8];
#pragma unroll
    for (int i = 0; i < 8; ++i) tv[i] = (4 * F.lane < ncols) ? *(const f32x4*)(W + (size_t)(k0 + F.wave * 8 + i) * ldn + n0 + 4 * F.lane) : (f32x4){0.f, 0.f, 0.f, 0.f};
    if (kscale) {
#pragma unroll
        for (int i = 0; i < 8; ++i) tv[i] = tv[i] * kscale[k0 + F.wave * 8 + i]; }
#pragma unroll
    for (int i = 0; i < 8; ++i) *(LAS f32x4*)(tile + (F.wave * 8 + i) * 260 + 4 * F.lane) = tv[i];
    LDS_BARRIER();
#pragma unroll
    for (int j = 0; j < 4; ++j) { const int n = F.lane + 64 * j; if (n < ncols) { const LAS float* sp = tile + (8 * F.wave) * 260 + n;
        u32x4 o; o.x = pk2(sp[0 * 260], sp[1 * 260]); o.y = pk2(sp[2 * 260], sp[3 * 260]); o.z = pk2(sp[4 * 260], sp[5 * 260]); o.w = pk2(sp[6 * 260], sp[7 * 260]);
        const int ng = n0 + n; const int orow = perm ? ((ng & ~255) + 128 * ((ng >> 5) & 1) + 32 * ((ng >> 6) & 3) + (ng & 31)) : ng;
        *(u32x4*)(WT + (size_t)orow * K + k0 + 8 * F.wave) = o; } }
    LDS_BARRIER();
}

__device__ __forceinline__ void p0_transpose_item(const float* W, int ldn, int K, bf16_t* WT, int out_row0, int k0, int n0, const float* kscale, LAS float* scr, int lane) {
    float tv[32];
#pragma unroll
    for (int i = 0; i < 32; ++i) { const int kk = 2 * i + (lane >> 5); tv[i] = W[(size_t)(k0 + kk) * ldn + n0 + (lane & 31)]; }
    if (kscale) {
#pragma unroll
        for (int i = 0; i < 32; ++i) tv[i] *= kscale[k0 + 2 * i + (lane >> 5)]; }
#pragma unroll
    for (int i = 0; i < 32; ++i) scr[(2 * i + (lane >> 5)) * 33 + (lane & 31)] = tv[i];
    LDS_WAIT();
    const int c = lane & 7;
#pragma unroll
    for (int j = 0; j < 4; ++j) { const int n = (lane >> 3) + 8 * j; const LAS float* s = scr + (8 * c) * 33 + n;
        u32x4 o; o.x = pk2(s[0 * 33], s[1 * 33]); o.y = pk2(s[2 * 33], s[3 * 33]); o.z = pk2(s[4 * 33], s[5 * 33]); o.w = pk2(s[6 * 33], s[7 * 33]);
        *(u32x4*)(WT + (size_t)(out_row0 + n) * K + k0 + 8 * c) = o; }
    LDS_WAIT();
}


constexpr int SH_OUT = 16 * 32, SH_UP = 16 * 128, SH_DOWN = 64 * 32, SH_ITEMS = SH_OUT + SH_UP + SH_DOWN, SH_PER_SEAM = SH_ITEMS / 3;
__device__ __forceinline__ void shadow_weight_item(const Ctx& F, int it) {
    LAS float* scr = (LAS float*)(F.lds + F.wave * 8448);
    int r = it;
    if (r < SH_OUT) { const int kb = r / 32, nb = r % 32; p0_transpose_item(F.w_out, D, D, F.Wout, 32 * nb, 64 * kb, 32 * nb, nullptr, scr, F.lane); return; }
    r -= SH_OUT;
    if (r < SH_UP) { const int kb = r / 128, nb = r % 128; p0_transpose_item(F.w_up, FF, D, F.Wup, 32 * nb, 64 * kb, 32 * nb, F.mlp_norm_w, scr, F.lane); return; }
    r -= SH_UP;
    { const int kb = r / 32, nb = r % 32; p0_transpose_item(F.w_down, D, FF, F.Wdown, 32 * nb, 64 * kb, 32 * nb, nullptr, scr, F.lane); }
}
__device__ __forceinline__ void shadow_weights(const Ctx& F, int seam) {
    if (F.wave == 0) return;
    const int nsw = F.G * 7;
    for (int i = blockIdx.x * 7 + (F.wave - 1); i < SH_PER_SEAM; i += nsw) shadow_weight_item(F, seam * SH_PER_SEAM + i);
}

__device__ __forceinline__ void p0_prologue(const Ctx& F) {
    const int gw = blockIdx.x * 8 + F.wave, NGW = F.G * 8;
    constexpr int I_IN = 16 * 16;
    for (int it = blockIdx.x; it < I_IN; it += F.G) p0_transpose_tile(F, F.w_in, INW, D, F.Win, 64 * (it / 16), 192 * (it % 16), 192, true, nullptr);
    for (int idx = blockIdx.x * 512 + F.tid; idx < SEQ * 32; idx += F.G * 512) {
        const int t = idx >> 5, d = idx & 31;
        double p = 1.0; for (int i = 0; i < d; ++i) p *= 0.74989420933245582730;
        const float invf = (float)p, ang = (float)t * invf;
        const double r = (double)ang, k = __builtin_rint(r * 0.63661977236758134308);
        double rr = __builtin_fma(-k, 1.57079632679489655800, r); rr = __builtin_fma(-k, 6.123233995736766036e-17, rr);
        const double r2 = rr * rr;
        const double sp = rr * (1.0 + r2 * (-1.0 / 6 + r2 * (1.0 / 120 + r2 * (-1.0 / 5040 + r2 * (1.0 / 362880 + r2 * (-1.0 / 39916800 + r2 * (1.0 / 6227020800.0)))))));
        const double cp = 1.0 + r2 * (-0.5 + r2 * (1.0 / 24 + r2 * (-1.0 / 720 + r2 * (1.0 / 40320 + r2 * (-1.0 / 3628800 + r2 * (1.0 / 479001600.0 + r2 * (-1.0 / 87178291200.0)))))));
        const int qd = ((int)k) & 3;
        const double sv = (qd == 0) ? sp : (qd == 1) ? cp : (qd == 2) ? -sp : -cp;
        const double cv = (qd == 0) ? cp : (qd == 1) ? -sp : (qd == 2) ? -cp : sp;
        F.ROPEC[idx] = (float)cv; F.ROPES[idx] = (float)sv;
    }
    REP(9) {
        f32x4 wd[4][4][2];
#pragma unroll
        for (int j = 0; j < 4; ++j)
#pragma unroll
            for (int e = 0; e < 4; ++e) { const float* wp = F.w_in + (size_t)(4 * F.lane + 256 * j + e) * INW + NPROJ; wd[j][e][0] = *(const f32x4*)wp; wd[j][e][1] = *(const f32x4*)(wp + 4); }
        const int qsel = 4 * (F.lane & 1) + 2 * ((F.lane >> 1) & 1) + ((F.lane >> 2) & 1);
        const float dtb = F.dt_bias[qsel];
        f32x4 v[4];
        if (gw < M) {
#pragma unroll
            for (int j = 0; j < 4; ++j) v[j] = ((const f32x4*)(F.x + (size_t)gw * D))[F.lane + 64 * j]; }
        for (int m = gw; m < M; m += NGW) {
            f32x4 vn[4]; const int mn = (m + NGW < M) ? m + NGW : m;
#pragma unroll
            for (int j = 0; j < 4; ++j) vn[j] = ((const f32x4*)(F.x + (size_t)mn * D))[F.lane + 64 * j];
            float ss = 0.f;
#pragma unroll
            for (int j = 0; j < 4; ++j) ss += (v[j][0] * v[j][0] + v[j][1] * v[j][1]) + (v[j][2] * v[j][2] + v[j][3] * v[j][3]);
            const float rstd = rsqrtf(wave_sum(ss) * (1.0f / D) + 1e-6f);
            if (F.lane == 0) F.RS[m] = rstd;
            typedef float f32x2v __attribute__((ext_vector_type(2)));
            f32x2v ac2[4];
#pragma unroll
            for (int q = 0; q < 4; ++q) ac2[q] = (f32x2v){0.f, 0.f};
            u32x2* o8 = (u32x2*)(F.H + (size_t)m * D) + F.lane;
#pragma unroll
            for (int j = 0; j < 4; ++j) {
                const f32x4 h = v[j] * rstd * ((const f32x4*)F.attn_norm_w)[F.lane + 64 * j];
                u32x2 o; o.x = pk2(h[0], h[1]); o.y = pk2(h[2], h[3]); o8[64 * j] = o;
#pragma unroll
                for (int e = 0; e < 4; ++e) { const f32x4 w0 = wd[j][e][0], w1 = wd[j][e][1]; const f32x2v hh2 = (f32x2v){h[e], h[e]};
                    ac2[0] += hh2 * (f32x2v){w0[0], w0[1]}; ac2[1] += hh2 * (f32x2v){w0[2], w0[3]};
                    ac2[2] += hh2 * (f32x2v){w1[0], w1[1]}; ac2[3] += hh2 * (f32x2v){w1[2], w1[3]}; }
            }
            const float acc[8] = {ac2[0][0], ac2[0][1], ac2[1][0], ac2[1][1], ac2[2][0], ac2[2][1], ac2[3][0], ac2[3][1]};
            float t4[4], t2[2], t1;
            { const bool b = (F.lane & 1) != 0;
#pragma unroll
              for (int i = 0; i < 4; ++i) { const float send = b ? acc[i] : acc[i + 4], keep = b ? acc[i + 4] : acc[i]; t4[i] = keep + __shfl_xor(send, 1); } }
            { const bool b = (F.lane & 2) != 0;
#pragma unroll
              for (int i = 0; i < 2; ++i) { const float send = b ? t4[i] : t4[i + 2], keep = b ? t4[i + 2] : t4[i]; t2[i] = keep + __shfl_xor(send, 2); } }
            { const bool b = (F.lane & 4) != 0; const float send = b ? t2[0] : t2[1], keep = b ? t2[1] : t2[0]; t1 = keep + __shfl_xor(send, 4); }
            t1 += __shfl_xor(t1, 8); t1 += __shfl_xor(t1, 16); t1 += __shfl_xor(t1, 32);
            if (F.lane < 8) { const float z = t1 + dtb; const float sp = (z > 20.f) ? z : log1pf(__expf(z)); F.DT[(size_t)m * 8 + qsel] = sp; }
#pragma unroll
            for (int j = 0; j < 4; ++j) v[j] = vn[j];
        }
    }
}

__device__ __forceinline__ void ssda_unit(const Ctx& F, int u) {
    const int g = u & 1, c = (u >> 1) & 15, b = u >> 5; const size_t row0 = (size_t)b * SEQ + c * 128;
    LAS unsigned char* lds = F.lds; const int lane = F.lane;
    LAS unsigned char* bimg = lds + 65536; LAS unsigned char* cimg = lds + 100352;
    LAS float* acs = (LAS float*)(lds + 135168); LAS float* dtl = (LAS float*)(lds + 137216); LAS float* dec = (LAS float*)(lds + 139264);
    if (F.wave < 4) {
        const int head = 4 * g + F.wave; const float a = -__expf(F.a_log[head]); const int l0 = 2 * lane;
        const float d0 = F.DT[(row0 + l0) * 8 + head], d1 = F.DT[(row0 + l0 + 1) * 8 + head]; const float a0 = a * d0, a1 = a * d1; float v = a0 + a1;
#pragma unroll
        for (int o = 1; o < 64; o <<= 1) { const float t = __shfl_up(v, o); if (lane >= o) v += t; }
        const float aend = __shfl(v, 63);
        acs[F.wave * 128 + l0] = v - a1; acs[F.wave * 128 + l0 + 1] = v; dtl[F.wave * 128 + l0] = d0; dtl[F.wave * 128 + l0 + 1] = d1;
        dec[F.wave * 128 + l0] = __expf(aend - (v - a1)); dec[F.wave * 128 + l0 + 1] = __expf(aend - v);
        F.ACS[(row0 + l0) * 8 + head] = v - a1; F.ACS[(row0 + l0 + 1) * 8 + head] = v;
    }
    LDS_BARRIER();
    {
        const int cg8 = F.tid & 63, tg = F.tid >> 6;
        const int ch = cg8 < 32 ? 256 * g + 8 * cg8 : (cg8 < 48 ? 512 + 128 * g + 8 * (cg8 - 32) : 768 + 128 * g + 8 * (cg8 - 48));
        float w0[8], w1[8], w2[8], w3[8], bs[8], u0[8], u1[8], u2[8];
#pragma unroll
        for (int e = 0; e < 8; ++e) { w0[e] = F.conv_w[ch + e]; w1[e] = F.conv_w[1024 + ch + e]; w2[e] = F.conv_w[2048 + ch + e]; w3[e] = F.conv_w[3072 + ch + e]; bs[e] = F.conv_b[ch + e]; }
        const int t0 = c * 128 + 16 * tg;
        const bf16_t* src = F.PROJ + (size_t)b * SEQ * NPROJ + 2048 + ch;
#define CVTROW(dst, r_) do { dst[0] = bflo(r_.x); dst[1] = bfhi(r_.x); dst[2] = bflo(r_.y); dst[3] = bfhi(r_.y); dst[4] = bflo(r_.z); dst[5] = bfhi(r_.z); dst[6] = bflo(r_.w); dst[7] = bfhi(r_.w); } while (0)
        const int xhl = (cg8 >> 3) & 3;
#pragma unroll 1
        for (int hb = 0; hb < 2; ++hb) {
            u32x4 raw[11];
#pragma unroll
            for (int k = 0; k < 11; ++k) { const int tt = t0 + 8 * hb - 3 + k; raw[k] = (tt >= 0) ? *(const u32x4*)(src + (size_t)tt * NPROJ) : (u32x4){0u, 0u, 0u, 0u}; }
            CVTROW(u0, raw[0]); CVTROW(u1, raw[1]); CVTROW(u2, raw[2]);
#pragma unroll
            for (int li = 0; li < 8; ++li) {
                const int l = 16 * tg + 8 * hb + li; float u3[8], y[8];
                CVTROW(u3, raw[li + 3]);
#pragma unroll
                for (int e = 0; e < 8; ++e) { const float sv = bs[e] + w0[e] * u0[e] + w1[e] * u1[e] + w2[e] * u2[e] + w3[e] * u3[e]; y[e] = silu_f(sv); u0[e] = u1[e]; u1[e] = u2[e]; u2[e] = u3[e]; }
                u32x4 o; o.x = pk2(y[0], y[1]); o.y = pk2(y[2], y[3]); o.z = pk2(y[4], y[5]); o.w = pk2(y[6], y[7]);
                if (cg8 < 32) {
                    const float sc = dtl[xhl * 128 + l];
                    u32x4 sx; sx.x = pk2(y[0] * sc, y[1] * sc); sx.y = pk2(y[2] * sc, y[3] * sc); sx.z = pk2(y[4] * sc, y[5] * sc); sx.w = pk2(y[6] * sc, y[7] * sc);
                    const int p = (8 * cg8) & 63;
                    *(LAS u32x4*)(lds + xhl * 16384 + (p >> 5) * 8192 + l * 64 + (p & 31) * 2) = sx;
                } else if (cg8 < 48) {
                    *(LAS u32x4*)(bimg + l * 272 + 16 * (cg8 - 32)) = o;
                } else {
                    *(LAS u32x4*)(cimg + l * 272 + 16 * (cg8 - 48)) = o;
                    *(u32x4*)(F.CC + (row0 + l) * 256 + 128 * g + 8 * (cg8 - 48)) = o;
                }
            }
        }
#undef CVTROW
    }
    LDS_BARRIER();
    {
        const int hl = F.wave >> 1, ph = F.wave & 1, hh = lane >> 5;
        const int trow = 8 * hh + ((lane & 15) >> 2), tcol = 16 * ((lane >> 4) & 1) + 4 * (lane & 3);
        const LAS unsigned char* xa = lds + hl * 16384 + ph * 8192 + trow * 64 + tcol * 2; const LAS unsigned char* ba = bimg + trow * 272 + tcol * 2;
        f32x16 acc[4];
#pragma unroll
        for (int nb = 0; nb < 4; ++nb) acc[nb] = (f32x16){0.f};
#pragma unroll
        for (int ks = 0; ks < 8; ++ks) {
            const s16x4 xlo = trd(xa + ks * 1024), xhi = trd(xa + ks * 1024 + 256);
            const f32x4 dlo = *(const LAS f32x4*)(dec + hl * 128 + 16 * ks + 8 * hh), dhi = *(const LAS f32x4*)(dec + hl * 128 + 16 * ks + 8 * hh + 4);
            u32x4 aw;
            aw.x = pk2(__uint_as_float((unsigned)(unsigned short)xlo[0] << 16) * dlo[0], __uint_as_float((unsigned)(unsigned short)xlo[1] << 16) * dlo[1]);
            aw.y = pk2(__uint_as_float((unsigned)(unsigned short)xlo[2] << 16) * dlo[2], __uint_as_float((unsigned)(unsigned short)xlo[3] << 16) * dlo[3]);
            aw.z = pk2(__uint_as_float((unsigned)(unsigned short)xhi[0] << 16) * dhi[0], __uint_as_float((unsigned)(unsigned short)xhi[1] << 16) * dhi[1]);
            aw.w = pk2(__uint_as_float((unsigned)(unsigned short)xhi[2] << 16) * dhi[2], __uint_as_float((unsigned)(unsigned short)xhi[3] << 16) * dhi[3]);
            const bf16x8 af = __builtin_bit_cast(bf16x8, aw);
#pragma unroll
            for (int nb = 0; nb < 4; ++nb) { const LAS unsigned char* bp = ba + (16 * ks) * 272 + nb * 64; const bf16x8 bf = cat8(trd(bp), trd(bp + 4 * 272)); acc[nb] = mfma32(af, bf, acc[nb]); }
        }
        bf16_t* cs = F.CS + ((size_t)((b * 16 + c) * 8 + 4 * g + hl)) * 8192 + (lane & 31);
#pragma unroll
        for (int nb = 0; nb < 4; ++nb)
#pragma unroll
            for (int i = 0; i < 16; i += 2) { const int p = 32 * ph + (i & 3) + 8 * (i >> 2) + 4 * hh; const unsigned w2 = pk2(acc[nb][i], acc[nb][i + 1]);
                cs[(size_t)p * 128 + 32 * nb] = (bf16_t)(w2 & 0xffffu); cs[(size_t)(p + 1) * 128 + 32 * nb] = (bf16_t)(w2 >> 16); }
    }
    {
        const int hl = F.wave >> 1, head = 4 * g + hl, lq = lane & 31, hh = lane >> 5;
        const float dsk = F.d_skip[head];
        const int tra = (4 * hh + ((lane & 15) >> 2)) * 64 + (16 * ((lane >> 4) & 1) + 4 * (lane & 3)) * 2;
#pragma unroll 1
        for (int lbi = 0; lbi < 2; ++lbi) {
            const int lb = (F.wave & 1) ? (1 + lbi) : (3 * lbi);
            const int l = 32 * lb + lq; const float acl = acs[hl * 128 + l]; const float rdt = 1.0f / dtl[hl * 128 + l];
            bf16x8 cf[8];
#pragma unroll
            for (int ks = 0; ks < 8; ++ks) cf[ks] = *(const LAS bf16x8*)(cimg + l * 272 + (16 * ks + 8 * hh) * 2);
            f32x16 acc[2]; acc[0] = (f32x16){0.f}; acc[1] = (f32x16){0.f};
            for (int sb = 0; sb <= lb; ++sb) {
                f32x16 gt = (f32x16){0.f};
                { const LAS unsigned char* bp = bimg + (32 * sb + lq) * 272 + 16 * hh;
#pragma unroll
                  for (int ks = 0; ks < 8; ++ks) gt = mfma32(*(const LAS bf16x8*)(bp + 32 * ks), cf[ks], gt); }
                float pg[16];
#pragma unroll
                for (int i = 0; i < 16; ++i) { const int sl = (i & 3) + 8 * (i >> 2) + 4 * hh; const float e = __expf(acl - acs[hl * 128 + 32 * sb + sl]);
                    pg[i] = (sb < lb || sl <= lq) ? gt[i] * e : 0.f; }
                bf16x8 pf0, pf1;
                { u32x4 a4; a4.x = pk2(pg[0], pg[1]); a4.y = pk2(pg[2], pg[3]); a4.z = pk2(pg[4], pg[5]); a4.w = pk2(pg[6], pg[7]); pf0 = __builtin_bit_cast(bf16x8, a4);
                  u32x4 d4; d4.x = pk2(pg[8], pg[9]); d4.y = pk2(pg[10], pg[11]); d4.z = pk2(pg[12], pg[13]); d4.w = pk2(pg[14], pg[15]); pf1 = __builtin_bit_cast(bf16x8, d4); }
                const LAS unsigned char* xb = lds + hl * 16384 + (32 * sb) * 64 + tra;
#pragma unroll
                for (int ph = 0; ph < 2; ++ph) { const LAS unsigned char* xp = xb + ph * 8192;
                    acc[ph] = mfma32(cat8(trd(xp), trd(xp + 512)), pf0, acc[ph]); acc[ph] = mfma32(cat8(trd(xp + 1024), trd(xp + 1536)), pf1, acc[ph]); }
            }
            const LAS unsigned char* xp = lds + hl * 16384 + l * 64 + 8 * hh; bf16_t* op = F.MIX + (row0 + l) * 1024 + 512 + 256 * g + 64 * hl + 4 * hh;
#pragma unroll
            for (int ph = 0; ph < 2; ++ph)
#pragma unroll
                for (int k4 = 0; k4 < 4; ++k4) { const u32x2 xw = *(const LAS u32x2*)(xp + ph * 8192 + 16 * k4);
                    const float xs[4] = {bflo(xw.x), bfhi(xw.x), bflo(xw.y), bfhi(xw.y)};
                    u32x2 o; o.x = pk2(acc[ph][4 * k4] + dsk * (xs[0] * rdt), acc[ph][4 * k4 + 1] + dsk * (xs[1] * rdt)); o.y = pk2(acc[ph][4 * k4 + 2] + dsk * (xs[2] * rdt), acc[ph][4 * k4 + 3] + dsk * (xs[3] * rdt));
                    *(u32x2*)(op + 32 * ph + 8 * k4) = o; }
        }
    }
    LDS_BARRIER();
}

struct AU { int b, h, br, dsh, grp; };
__device__ __forceinline__ AU au_decode(int u) { AU a; a.grp = u & 7; int combo = u >> 3; a.br = combo % 3; combo /= 3; a.h = combo & 7; a.b = combo >> 3; a.dsh = 2 * a.br; return a; }
__device__ __forceinline__ int au_key_token(const AU& a, int j) {
    if (a.br == 2) return (j < 256) ? (2 * a.grp + (j >> 7)) + 16 * (j & 127) : -1;
    const int r = a.br == 0 ? 0 : (a.grp >> 1), base = a.br == 0 ? 256 * a.grp : 256 * (a.grp & 1), idx = base - 128 + j;
    return idx >= 0 ? r + (idx << a.dsh) : -1;
}
__device__ __forceinline__ void au_issue(const Ctx& F, int u, bf16x8 (&kr)[6], bf16x8 (&vr)[6], bf16x8 (&qn)[4]) {
    const AU a = au_decode(u); const int srow = F.tid >> 3, c8 = F.tid & 7, q = F.lane & 31, hh = F.lane >> 5, w = F.wave;
    const bf16_t* base = F.PROJ + (size_t)a.b * SEQ * NPROJ + a.h * 64;
#pragma unroll
    for (int i = 0; i < 6; ++i) { const int tok = au_key_token(a, 64 * i + srow);
        if (tok >= 0) { const bf16_t* p = base + (size_t)tok * NPROJ + 512 + 8 * c8; kr[i] = *(const bf16x8*)p; vr[i] = *(const bf16x8*)(p + 512); }
        else { kr[i] = (bf16x8){0, 0, 0, 0, 0, 0, 0, 0}; vr[i] = kr[i]; } }
    int qtok;
    if (a.br == 2) qtok = (2 * a.grp + (w >> 2)) + 16 * (32 * (w & 3) + q);
    else { const int r = a.br == 0 ? 0 : (a.grp >> 1), bq = a.br == 0 ? 256 * a.grp : 256 * (a.grp & 1); qtok = r + ((bq + 32 * w + q) << a.dsh); }
    const bf16_t* qp = base + (size_t)qtok * NPROJ + 8 * hh;
#pragma unroll
    for (int s = 0; s < 4; ++s) qn[s] = *(const bf16x8*)(qp + 16 * s);
}
__device__ __forceinline__ void attn_phase(const Ctx& F, float ref2) {
    constexpr int NU = 8 * 8 * 3 * 8;
    const int lane = F.lane, w = F.wave, q = lane & 31, hh = lane >> 5, srow = F.tid >> 3, c8 = F.tid & 7;
    LAS unsigned char* kimg = F.lds; LAS unsigned char* vimg = F.lds + 55296; LAS unsigned char* oimg = F.lds + 104448 + w * 4608;
    const int tra = (4 * hh + ((lane & 15) >> 2)) * 64 + (16 * ((lane >> 4) & 1) + 4 * (lane & 3)) * 2;
    bf16x8 kr[6], vr[6], qn[4];
    f32x16 negref;
#pragma unroll
    for (int i = 0; i < 16; ++i) negref[i] = -ref2;
    const bool xcdmap = (F.G % 8) == 0; const int ustep = xcdmap ? F.G / 8 : F.G, ubase = xcdmap ? (int)(blockIdx.x & 7) * (NU / 8) : 0, uend = xcdmap ? NU / 8 : NU;
    int ui = xcdmap ? (int)(blockIdx.x >> 3) : (int)blockIdx.x;
    if (ui < uend) au_issue(F, ubase + ui, kr, vr, qn);
    for (; ui < uend; ui += ustep) {
        const int u = ubase + ui;
        const AU a = au_decode(u);
        bf16x8 qf[4];
#pragma unroll
        for (int s = 0; s < 4; ++s) qf[s] = qn[s];
#pragma unroll
        for (int i = 0; i < 6; ++i) { const int j = 64 * i + srow;
            *(LAS bf16x8*)(kimg + j * 144 + c8 * 16) = kr[i];
            *(LAS bf16x8*)(vimg + (j >> 5) * 4096 + (c8 >> 2) * 2048 + (j & 31) * 64 + (c8 & 3) * 16) = vr[i]; }
        LDS_BARRIER();
        if (ui + ustep < uend) au_issue(F, u + ustep, kr, vr, qn);
        int kt0, st0, i0, qtok0;
        if (a.br == 2) { const int qt = w & 3; kt0 = 4 - qt; st0 = 4 * (w >> 2) + qt - 4; i0 = 32 * qt; qtok0 = 2 * a.grp + (w >> 2); }
        else { const int bq = a.br == 0 ? 256 * a.grp : 256 * (a.grp & 1); const int qtg = (bq >> 5) + w; kt0 = 4 - qtg; if (kt0 < 0) kt0 = 0; st0 = w; i0 = bq + 32 * w; qtok0 = a.br == 0 ? 0 : (a.grp >> 1); }
        f32x16 o0 = (f32x16){0.f}, o1 = (f32x16){0.f}; float lsum = 0.f;
        for (int kt = kt0; kt <= 4; ++kt) {
            const int st = st0 + kt;
            const LAS unsigned char* kp = kimg + (32 * st + q) * 144 + 16 * hh; const LAS unsigned char* vp = vimg + st * 4096 + tra;
            f32x16 sc = negref;
#pragma unroll
            for (int s = 0; s < 4; ++s) sc = mfma32(*(const LAS bf16x8*)(kp + 32 * s), qf[s], sc);
            float p[16];
#pragma unroll
            for (int i = 0; i < 16; ++i) p[i] = __builtin_amdgcn_exp2f(sc[i]);
            if (kt == 0) {
#pragma unroll
                for (int i = 0; i < 16; ++i) { const int kv = (i & 3) + 8 * (i >> 2) + 4 * hh; if (kv < q) p[i] = 0.f; } }
            if (kt == 4) {
#pragma unroll
                for (int i = 0; i < 16; ++i) { const int kv = (i & 3) + 8 * (i >> 2) + 4 * hh; if (kv > q) p[i] = 0.f; } }
#pragma unroll
            for (int i = 0; i < 16; ++i) lsum += p[i];
            bf16x8 pf0, pf1;
            { u32x4 x; x.x = pk2(p[0], p[1]); x.y = pk2(p[2], p[3]); x.z = pk2(p[4], p[5]); x.w = pk2(p[6], p[7]); pf0 = __builtin_bit_cast(bf16x8, x);
              u32x4 y; y.x = pk2(p[8], p[9]); y.y = pk2(p[10], p[11]); y.z = pk2(p[12], p[13]); y.w = pk2(p[14], p[15]); pf1 = __builtin_bit_cast(bf16x8, y); }
            { const bf16x8 a00 = cat8(trd(vp), trd(vp + 512)), a01 = cat8(trd(vp + 1024), trd(vp + 1536));
              const bf16x8 a10 = cat8(trd(vp + 2048), trd(vp + 2048 + 512)), a11 = cat8(trd(vp + 2048 + 1024), trd(vp + 2048 + 1536));
              o0 = mfma32(a00, pf0, o0); o0 = mfma32(a01, pf1, o0); o1 = mfma32(a10, pf0, o1); o1 = mfma32(a11, pf1, o1); }
        }
        lsum += __shfl_xor(lsum, 32);
#pragma unroll
        for (int g4 = 0; g4 < 4; ++g4) {
            u32x2 x; x.x = pk2(o0[4 * g4], o0[4 * g4 + 1]); x.y = pk2(o0[4 * g4 + 2], o0[4 * g4 + 3]); *(LAS u32x2*)(oimg + q * 144 + (8 * g4 + 4 * hh) * 2) = x;
            u32x2 y; y.x = pk2(o1[4 * g4], o1[4 * g4 + 1]); y.y = pk2(o1[4 * g4 + 2], o1[4 * g4 + 3]); *(LAS u32x2*)(oimg + q * 144 + (32 + 8 * g4 + 4 * hh) * 2) = y; }
        LDS_WAIT();
        { const int rowi = lane >> 3, cc = lane & 7;
          bf16_t* op = F.OP + ((size_t)a.br * M + (size_t)a.b * SEQ + qtok0) * 512 + a.h * 64 + 8 * cc;
#pragma unroll
          for (int i = 0; i < 4; ++i) __builtin_nontemporal_store(*(const LAS u32x4*)(oimg + (8 * i + rowi) * 144 + cc * 16), (u32x4*)(op + ((size_t)(i0 + 8 * i + rowi) << a.dsh) * 512)); }
        if (hh == 0) F.LP[((size_t)a.br * M + (size_t)a.b * SEQ + qtok0 + ((size_t)(i0 + q) << a.dsh)) * 8 + a.h] = lsum;
        LDS_BARRIER();
    }
}

__device__ __forceinline__ void p3_scan_merge(const Ctx& F) {
    const int gt = blockIdx.x * 512 + F.tid, NT = F.G * 512;
    for (int idx = gt; idx < 8 * 8 * 64 * 32; idx += NT) {
        const int n4 = idx & 31, p = (idx >> 5) & 63, hd = (idx >> 11) & 7, b = idx >> 14;
        f32x4 st = (f32x4){0.f, 0.f, 0.f, 0.f};
        const size_t off0 = ((size_t)(b * 16 * 8 + hd)) * 8192 + p * 128 + 4 * n4;
        u32x2 cw[15]; float da[15];
#pragma unroll
        for (int c = 0; c < 15; ++c) { cw[c] = __builtin_nontemporal_load((const u32x2*)(F.CS + off0 + (size_t)c * 65536)); da[c] = F.ACS[((size_t)b * SEQ + c * 128 + 127) * 8 + hd]; }
        asm volatile("" ::: "memory");
#pragma unroll
        for (int c = 0; c < 16; ++c) {
            u32x2 o; o.x = pk2(st[0], st[1]); o.y = pk2(st[2], st[3]); *(u32x2*)(F.SIN + off0 + (size_t)c * 65536) = o;
            if (c < 15) st = st * __expf(da[c]) + (f32x4){bflo(cw[c].x), bfhi(cw[c].x), bflo(cw[c].y), bfhi(cw[c].y)};
        }
    }
    for (int it = gt; it < M * 64; it += NT) {
        const int dc = it & 7, h = (it >> 3) & 7; const size_t row = (size_t)(it >> 6);
        float l = 0.f; float o[8];
#pragma unroll
        for (int e = 0; e < 8; ++e) o[e] = 0.f;
#pragma unroll
        for (int br = 0; br < 3; ++br) {
            l += F.LP[((size_t)br * M + row) * 8 + h];
            const u32x4 w = __builtin_nontemporal_load((const u32x4*)(F.OP + ((size_t)br * M + row) * 512 + h * 64 + 8 * dc));
            o[0] += bflo(w.x); o[1] += bfhi(w.x); o[2] += bflo(w.y); o[3] += bfhi(w.y); o[4] += bflo(w.z); o[5] += bfhi(w.z); o[6] += bflo(w.w); o[7] += bfhi(w.w);
        }
        const float inv = 1.0f / l;
        u32x4 r; r.x = pk2(o[0] * inv, o[1] * inv); r.y = pk2(o[2] * inv, o[3] * inv); r.z = pk2(o[4] * inv, o[5] * inv); r.w = pk2(o[6] * inv, o[7] * inv);
        *(u32x4*)(F.MIX + row * 1024 + h * 64 + 8 * dc) = r;
    }
}

__device__ __forceinline__ void ssdb_issue(const Ctx& F, int u, u32x2 (&zr)[2][4], u32x2 (&yr)[2][4], u32x4 (&cr4)[4], float (&eal)[2]) {
    const int g = u & 1, c = (u >> 1) & 15, b = u >> 5; const size_t row0 = (size_t)b * SEQ + c * 128;
    const int hl = F.wave >> 1, head = 4 * g + hl, lq = F.lane & 31, hh = F.lane >> 5;
#pragma unroll
    for (int lbi = 0; lbi < 2; ++lbi) { const int lb = (F.wave & 1) ? (1 + lbi) : (3 * lbi); eal[lbi] = F.ACS[(row0 + 32 * lb + lq) * 8 + head]; }
    {   const int l = 32 * ((F.wave & 1) ? 1 : 0) + lq;
        const bf16_t* op = F.MIX + (row0 + l) * 1024 + 512 + 256 * g + 64 * hl + 4 * hh; const bf16_t* zp = F.PROJ + (row0 + l) * NPROJ + 1536 + 256 * g + 64 * hl + 4 * hh;
#pragma unroll
        for (int ph = 0; ph < 2; ++ph)
#pragma unroll
            for (int k4 = 0; k4 < 4; ++k4) { zr[ph][k4] = *(const u32x2*)(zp + 32 * ph + 8 * k4); yr[ph][k4] = *(const u32x2*)(op + 32 * ph + 8 * k4); }
    }
    const int brow = F.tid >> 4, bcol = 8 * (F.tid & 15);
    const bf16_t* bp = F.CC + (row0 + brow) * 256 + 128 * g + bcol;
#pragma unroll
    for (int i = 0; i < 4; ++i) cr4[i] = *(const u32x4*)(bp + (size_t)(32 * i) * 256);
}
__device__ __forceinline__ void ssdb_unit(const Ctx& F, int u, const u32x2 (&zr)[2][4], const u32x2 (&yr)[2][4], const u32x4 (&cr4)[4], const float (&ealv)[2]) {
    const int g = u & 1, c = (u >> 1) & 15, b = u >> 5; const size_t row0 = (size_t)b * SEQ + c * 128;
    LAS unsigned char* lds = F.lds; const int lane = F.lane;
    LAS unsigned char* cimg = lds; LAS float* ssq = (LAS float*)(lds + 34816);
    const int hl = F.wave >> 1, head = 4 * g + hl, lq = lane & 31, hh = lane >> 5;
    bf16x8 sin[2][8];
    { const bf16_t* sp = F.SIN + ((size_t)((b * 16 + c) * 8 + head)) * 8192 + (size_t)lq * 128 + 8 * hh;
#pragma unroll
      for (int ph = 0; ph < 2; ++ph)
#pragma unroll
          for (int ks = 0; ks < 8; ++ks) sin[ph][ks] = *(const bf16x8*)(sp + (size_t)ph * 32 * 128 + 16 * ks); }
    { const int brow = F.tid >> 4, bcol = 8 * (F.tid & 15);
#pragma unroll
      for (int i = 0; i < 4; ++i) *(LAS u32x4*)(cimg + (brow + 32 * i) * 272 + bcol * 2) = cr4[i]; }
    LDS_BARRIER();
    u32x2 z1[2][4], y1[2][4];
#pragma unroll
    for (int lbi = 0; lbi < 2; ++lbi) {
        const int lb = (F.wave & 1) ? (1 + lbi) : (3 * lbi);
        const int l = 32 * lb + lq;
        const float eal = __expf(ealv[lbi]);
        bf16_t* op = F.MIX + (row0 + l) * 1024 + 512 + 256 * g + 64 * hl + 4 * hh;
        if (lbi == 0) {
            const int l1 = 32 * ((F.wave & 1) ? 2 : 3) + lq;
            const bf16_t* op1 = F.MIX + (row0 + l1) * 1024 + 512 + 256 * g + 64 * hl + 4 * hh; const bf16_t* zp1 = F.PROJ + (row0 + l1) * NPROJ + 1536 + 256 * g + 64 * hl + 4 * hh;
#pragma unroll
            for (int ph = 0; ph < 2; ++ph)
#pragma unroll
                for (int k4 = 0; k4 < 4; ++k4) { z1[ph][k4] = *(const u32x2*)(zp1 + 32 * ph + 8 * k4); y1[ph][k4] = *(const u32x2*)(op1 + 32 * ph + 8 * k4); }
        }
        bf16x8 cf[8];
#pragma unroll
        for (int ks = 0; ks < 8; ++ks) cf[ks] = *(const LAS bf16x8*)(cimg + l * 272 + (16 * ks + 8 * hh) * 2);
        f32x16 acc[2];
#pragma unroll
        for (int ph = 0; ph < 2; ++ph) { f32x16 a = (f32x16){0.f};
#pragma unroll
            for (int ks = 0; ks < 8; ++ks) a = mfma32(sin[ph][ks], cf[ks], a);
            acc[ph] = a * eal; }
        float ss = 0.f;
#pragma unroll
        for (int ph = 0; ph < 2; ++ph)
#pragma unroll
            for (int k4 = 0; k4 < 4; ++k4) { const u32x2 yw = lbi == 0 ? yr[ph][k4] : y1[ph][k4], zw = lbi == 0 ? zr[ph][k4] : z1[ph][k4];
                const float ys[4] = {bflo(yw.x), bfhi(yw.x), bflo(yw.y), bfhi(yw.y)}, zs[4] = {bflo(zw.x), bfhi(zw.x), bflo(zw.y), bfhi(zw.y)};
#pragma unroll
                for (int e = 0; e < 4; ++e) { const float y = (acc[ph][4 * k4 + e] + ys[e]) * silu_f(zs[e]); acc[ph][4 * k4 + e] = y; ss += y * y; } }
        ss += __shfl_xor(ss, 32);
        if (hh == 0) ssq[lbi * 512 + hl * 128 + l] = ss;
        LDS_BARRIER();
        const LAS float* sq = ssq + lbi * 512 + l;
        const float rstd = rsqrtf(((sq[0] + sq[128]) + (sq[256] + sq[384])) * (1.0f / 256.0f) + 1e-6f);
        const float* wp = F.ssd_norm_w + 256 * g + 64 * hl + 4 * hh;
#pragma unroll
        for (int ph = 0; ph < 2; ++ph)
#pragma unroll
            for (int k4 = 0; k4 < 4; ++k4) { const f32x4 w = *(const f32x4*)(wp + 32 * ph + 8 * k4); const f32x16 y = acc[ph];
                u32x2 o; o.x = pk2(y[4 * k4] * rstd * w[0], y[4 * k4 + 1] * rstd * w[1]); o.y = pk2(y[4 * k4 + 2] * rstd * w[2], y[4 * k4 + 3] * rstd * w[3]);
                *(u32x2*)(op + 32 * ph + 8 * k4) = o; }
    }
    LDS_BARRIER();
}

struct Args { const float* in[15]; float* out; unsigned char* ws; int ph_lo, ph_hi; };
__global__ void __launch_bounds__(512) hybrid_fwd(Args args) {
    extern __shared__ __attribute__((aligned(16))) unsigned char lds_raw[];
    Ctx F;
    F.x = args.in[0]; F.attn_norm_w = args.in[1]; F.w_in = args.in[2]; F.q_norm_w = args.in[3]; F.k_norm_w = args.in[4]; F.conv_w = args.in[5]; F.conv_b = args.in[6];
    F.dt_bias = args.in[7]; F.a_log = args.in[8]; F.d_skip = args.in[9]; F.ssd_norm_w = args.in[10]; F.w_out = args.in[11]; F.mlp_norm_w = args.in[12]; F.w_up = args.in[13]; F.w_down = args.in[14];
    F.out = args.out; F.ws = args.ws; unsigned char* ws = args.ws;
    F.Win = (bf16_t*)(ws + WS_WIN); F.Wout = (bf16_t*)(ws + WS_WOUT); F.Wup = (bf16_t*)(ws + WS_WUP); F.Wdown = (bf16_t*)(ws + WS_WDOWN);
    F.H = (bf16_t*)(ws + WS_H); F.XBCC = (bf16_t*)(ws + WS_XBCC); F.PROJ = (bf16_t*)(ws + WS_PROJ); F.ACT = (bf16_t*)(ws + WS_ACT); F.MIX = (bf16_t*)(ws + WS_MIX);
    F.X1B = (bf16_t*)(ws + WS_X1B); F.SIN = (bf16_t*)(ws + WS_SIN); F.OP = (bf16_t*)args.out;
    F.ROPEC = (float*)(ws + WS_ROPE); F.ROPES = F.ROPEC + SEQ * 32; F.DT = (float*)(ws + WS_DT); F.ACS = (float*)(ws + WS_ACS); F.PART = (float*)(ws + WS_PART); F.LP = (float*)(ws + WS_LP); F.CS = (bf16_t*)(ws + WS_CS); F.CC = (bf16_t*)(ws + WS_CC); F.RS = (float*)(ws + WS_RS);
    F.lds = (LAS unsigned char*)lds_raw; F.tid = threadIdx.x; F.lane = F.tid & 63; F.wave = __builtin_amdgcn_readfirstlane(F.tid >> 6); F.G = gridDim.x;
    const int lo = args.ph_lo, hi = args.ph_hi;
#define IN(k) (lo <= (k) && (k) < hi)
#define SEAM(k) do { if (IN(k) && IN((k) + 1)) { xcd_barrier(bar); if ((MK_REPEAT >> 12) & 1) xcd_barrier(bar); } } while (0)
#define SEAM_SHADOW(k, seam, nodrain) do { if (IN(k) && IN((k) + 1)) { asm volatile("s_waitcnt vmcnt(0)" ::: "memory"); __syncthreads(); shadow_weights(F, seam); \
        if (threadIdx.x == 0) xcd_barrier_leader(bar); if (nodrain) LDS_BARRIER(); else __syncthreads(); } else if (IN(k)) { __syncthreads(); shadow_weights(F, seam); } } while (0)
    if (lo > 1000) cg::this_grid().sync();
    volatile LAS unsigned* bst = (volatile LAS unsigned*)(F.lds + LDS_BYTES - 16);
    if (F.tid < 2) bst[F.tid] = 0u;
    __syncthreads();
    XcdBarrier bar = xcd_barrier_post((unsigned*)(ws + WS_BAR), bst);

    if (IN(0)) REP(0) p0_prologue(F);
    SEAM(0);
    if (IN(1)) REP(1) { pg8::Gemm gm{F.H, F.Win, M, NPROJ, D}; pg8::StaticOrder S; S.init(M, NPROJ, F.G, (int)blockIdx.x);
        pg8::EpiInProj E{F.PROJ, F.q_norm_w, F.k_norm_w, F.ROPEC, F.ROPES};
        pg8::f32x4 lacc[2][2][4][2]; pg8::gemm_phase<pg8::EpiInProj, pg8::StaticOrder, true, true>(F.lds, gm, S, E, lacc); }
    SEAM_SHADOW(1, 0, true);
    if (IN(2)) REP(2) {
        for (int u = blockIdx.x; u < 256; u += F.G) ssda_unit(F, u);
        float mq = fabsf(F.q_norm_w[F.lane]), mk = fabsf(F.k_norm_w[F.lane]);
#pragma unroll
        for (int o = 1; o < 64; o <<= 1) { mq = fmaxf(mq, __shfl_xor(mq, o)); mk = fmaxf(mk, __shfl_xor(mk, o)); }
        const float ref2 = pg8::QSCALE * 64.0f * mq * mk;
        REP(11) attn_phase(F, ref2);
    }
    SEAM_SHADOW(2, 1, true);
    if (IN(3)) REP(3) p3_scan_merge(F);
    {
        u32x2 pzr[2][4], pyr[2][4]; u32x4 pcr[4]; float peal[2];
        const bool p4first = IN(4) && (int)blockIdx.x < 256;
        if (IN(3) && IN(4)) {
            asm volatile("s_waitcnt vmcnt(0)" ::: "memory"); __syncthreads();
            if (p4first && F.wave != 0) ssdb_issue(F, blockIdx.x, pzr, pyr, pcr, peal);
            if (threadIdx.x == 0) xcd_barrier_leader(bar);
            LDS_BARRIER();
            if (p4first && F.wave == 0) ssdb_issue(F, blockIdx.x, pzr, pyr, pcr, peal);
        } else if (p4first) ssdb_issue(F, blockIdx.x, pzr, pyr, pcr, peal);
        if (p4first) ssdb_unit(F, blockIdx.x, pzr, pyr, pcr, peal);
        if (IN(4)) {
#pragma unroll 1
            for (int u = blockIdx.x + F.G; u < 256; u += F.G) { ssdb_issue(F, u, pzr, pyr, pcr, peal); ssdb_unit(F, u, pzr, pyr, pcr, peal); } }
    }
    const int pwr = F.wave >> 2, pwc = F.wave & 3, pfr = F.lane & 15, pfq = F.lane >> 4;
    {   pg8::f32x4 gacc[2][2][4][2]; pg8::StaticOrder S; S.init(M, D, F.G, (int)blockIdx.x); pg8::Unit u0; const bool has = IN(5) && S.next(0, u0);
        if (IN(4) && IN(5)) {
            asm volatile("s_waitcnt vmcnt(0)" ::: "memory"); __syncthreads();
            if (has && F.wave != 0) pg8::preload_h_tile(gacc, F.H, F.RS, F.attn_norm_w, u0, pwr, pwc, pfr, pfq);
            if (threadIdx.x == 0) xcd_barrier_leader(bar);
            LDS_BARRIER();
            if (has && F.wave == 0) pg8::preload_h_tile(gacc, F.H, F.RS, F.attn_norm_w, u0, pwr, pwc, pfr, pfq);
        } else if (has) pg8::preload_h_tile(gacc, F.H, F.RS, F.attn_norm_w, u0, pwr, pwc, pfr, pfq);
        if (IN(5)) { pg8::Gemm gm{F.MIX, F.Wout, M, D, D};
            pg8::EpiOutProjPre E{F.X1B, F.PART};
            pg8::gemm_phase<pg8::EpiOutProjPre, pg8::StaticOrder, true, true, true>(F.lds, gm, S, E, gacc); }
    }
    SEAM_SHADOW(5, 2, false);
    if (IN(6)) { pg8::Gemm gm{F.X1B, F.Wup, M, FF, D}; pg8::StaticOrder S; S.init(M, FF, F.G, (int)blockIdx.x);
        LAS float* rt = (LAS float*)(F.lds + 131072 + 2048); int pmc = -1;
        { pg8::Unit u0; if (S.next(0, u0)) { pmc = u0.pm; const float* pp = F.PART + ((size_t)u0.pm * 256 + (F.tid >> 1)) * 16 + 8 * (F.tid & 1);
            const f32x4 a = *(const f32x4*)pp, b = *(const f32x4*)(pp + 4); float sq = ((a[0] + a[1]) + (a[2] + a[3])) + ((b[0] + b[1]) + (b[2] + b[3])); sq += __shfl_xor(sq, 1);
            if (!(F.tid & 1)) rt[F.tid >> 1] = rsqrtf(sq * (1.0f / 1024.0f) + 1e-6f); } }
        __syncthreads();
        pg8::EpiUpT E{F.ACT, F.PART, rt, pmc};
        pg8::f32x4 lacc[2][2][4][2]; pg8::gemm_phase<pg8::EpiUpT, pg8::StaticOrder, true, true>(F.lds, gm, S, E, lacc); }
    {   pg8::f32x4 gacc[2][2][4][2]; pg8::StaticOrder S; S.init(M, D, F.G, (int)blockIdx.x); pg8::Unit u0; const bool has = IN(7) && S.next(0, u0);
        if (IN(6) && IN(7)) {
            asm volatile("s_waitcnt vmcnt(0)" ::: "memory"); __syncthreads();
            if (has && F.wave != 0) pg8::preload_bf16_tile(gacc, F.X1B, u0, pwr, pwc, pfr, pfq);
            if (threadIdx.x == 0) xcd_barrier_leader(bar);
            LDS_BARRIER();
            if (has && F.wave == 0) pg8::preload_bf16_tile(gacc, F.X1B, u0, pwr, pwc, pfr, pfq);
        } else if (has) pg8::preload_bf16_tile(gacc, F.X1B, u0, pwr, pwc, pfr, pfq);
        if (IN(7)) { pg8::Gemm gm{F.ACT, F.Wdown, M, D, FF};
            pg8::EpiDownPre E{F.out};
            pg8::gemm_phase<pg8::EpiDownPre, pg8::StaticOrder, true, true, true>(F.lds, gm, S, E, gacc); }
    }
#undef IN
#undef SEAM
}

extern "C" void kernel_launch(void* const* d_in, const int* in_sizes, int n_in, void* d_out, int out_size, void* d_ws, size_t ws_size, hipStream_t stream) {
    static int grid = 0;
    if (grid == 0) {
        if (n_in != 15 || out_size != M * D || ws_size < WS_END) { fprintf(stderr, "kernel_launch: unexpected shapes (n_in %d, out %d, ws %zu)\n", n_in, out_size, ws_size); grid = -1; return; }
        int dev = 0, cus = 0, per_cu = 0;
        if (hipGetDevice(&dev) != hipSuccess || hipDeviceGetAttribute(&cus, hipDeviceAttributeMultiprocessorCount, dev) != hipSuccess) { grid = -1; return; }
        if (hipFuncSetAttribute((const void*)hybrid_fwd, hipFuncAttributeMaxDynamicSharedMemorySize, LDS_BYTES) != hipSuccess) { fprintf(stderr, "kernel_launch: hipFuncSetAttribute failed\n"); grid = -1; return; }
        if (hipOccupancyMaxActiveBlocksPerMultiprocessor(&per_cu, (const void*)hybrid_fwd, 512, LDS_BYTES) != hipSuccess || per_cu < 1) { fprintf(stderr, "kernel_launch: occupancy query says %d blocks per CU\n", per_cu); (void)hipGetLastError(); per_cu = 1; }
        grid = cus * per_cu;
    }
    if (grid < 0) return;
    if (hipMemsetAsync((char*)d_ws + WS_BAR, 0, XCD_BAR_WORDS * 4, stream) != hipSuccess) { fprintf(stderr, "kernel_launch: memset of the barrier words failed\n"); return; }
    Args a{};
    for (int i = 0; i < 15; ++i) a.in[i] = (const float*)d_in[i];
    a.out = (float*)d_out; a.ws = (unsigned char*)d_ws;
#if MK_SPLIT
    for (int ph = 0; ph < NPHASE; ++ph) { a.ph_lo = ph; a.ph_hi = ph + 1; hipLaunchKernelGGL(hybrid_fwd, dim3(grid), dim3(512), LDS_BYTES, stream, a); }
#else
    a.ph_lo = 0; a.ph_hi = NPHASE;
    void* kargs[] = {&a};
    const hipError_t e = hipLaunchCooperativeKernel((const void*)hybrid_fwd, dim3(grid), dim3(512), kargs, LDS_BYTES, stream);
    if (e != hipSuccess) fprintf(stderr, "kernel_launch: cooperative launch failed: %s (grid %d)\n", hipGetErrorString(e), grid);
#endif
}
```
